# Optimizing an MI355X kernel written in HIP

```python
import jax, jax.numpy as jnp
from jax import lax
import numpy as np

D_MODEL = 2048
BATCH = 8
SEQ = 2048
DEPTH = 4

HEAD_DIM = 128
ATTN_HEADS_PER_GROUP = 4
DILATED_GROUPS = ((128, 1), (512, 4), (2048, 16))
N_ATTN_GROUPS = len(DILATED_GROUPS)
GROUP_WIDTH = ATTN_HEADS_PER_GROUP * HEAD_DIM
ATTN_WIDTH = N_ATTN_GROUPS * GROUP_WIDTH
ATTN_OUT_WIDTH = GROUP_WIDTH
HGRN_HEADS = 8
HGRN_KEY_DIM = 128
HGRN_VAL_DIM = 128
HGRN_WIDTH = HGRN_HEADS * HGRN_KEY_DIM
HGRN_CHUNK = 64
D_FF = 5504
MACARON_WEIGHT = 0.5
EPS = 1e-6
MASK_VALUE = -1e30
SPLIT_SIZES = (ATTN_WIDTH, ATTN_WIDTH, ATTN_WIDTH,
               HGRN_WIDTH, HGRN_WIDTH, HGRN_HEADS * HGRN_VAL_DIM, HGRN_HEADS * HGRN_VAL_DIM,
               2 * D_MODEL)
IN_WIDTH = sum(SPLIT_SIZES)

kernel_name = "hybrid_dilated_attn_hgrn2_macaron"


def rms_norm(x, gain):
    xf = x.astype(jnp.float32)
    y = xf * lax.rsqrt(jnp.mean(xf * xf, axis=-1, keepdims=True) + EPS)
    return (y * gain.astype(jnp.float32)).astype(x.dtype)


def swiglu(h, w_in, w_out):
    gate, up = jnp.split(h @ w_in, 2, axis=-1)
    return (jax.nn.silu(gate) * up) @ w_out


def dilated_window_attention(q, k, v, window, dilation):
    B, S, H, Dh = q.shape
    r = dilation
    nb = window // dilation
    L = S // r
    nblk = -(-L // nb)
    pad = nblk * nb - L

    def to_blocks(t):
        t = t.reshape(B, L, r, H, Dh).transpose(0, 2, 3, 1, 4)
        t = jnp.pad(t, ((0, 0), (0, 0), (0, 0), (0, pad), (0, 0)))
        return t.reshape(B, r, H, nblk, nb, Dh)

    def with_prev(t):
        prev = jnp.concatenate([jnp.zeros_like(t[:, :, :, :1]), t[:, :, :, :-1]], axis=3)
        return jnp.concatenate([prev, t], axis=4)

    qb = to_blocks(q)
    kb = with_prev(to_blocks(k))
    vb = with_prev(to_blocks(v))
    s = jnp.einsum('brhnqd,brhnkd->brhnqk', qb, kb).astype(jnp.float32) * (Dh ** -0.5)
    qi = jnp.arange(nb)[:, None]
    kj = jnp.arange(2 * nb)[None, :]
    dist = nb + qi - kj
    blk = jnp.arange(nblk)[:, None, None]
    valid = (dist >= 0) & (dist <= nb) & ((blk > 0) | (kj >= nb))
    s = jnp.where(valid, s, MASK_VALUE)
    lse = jax.nn.logsumexp(s, axis=-1)
    p = jnp.exp(s - lse[..., None])
    o = jnp.einsum('brhnqk,brhnkd->brhnqd', p.astype(vb.dtype), vb)
    o = o.reshape(B, r, H, nblk * nb, Dh)[:, :, :, :L].transpose(0, 3, 1, 2, 4).reshape(B, S, H, Dh)
    lse = lse.reshape(B, r, H, nblk * nb)[..., :L].transpose(0, 3, 1, 2).reshape(B, S, H)
    return o, lse


def dilated_attention_branch(q, k, v):
    B, S, _ = q.shape
    outs, lses = [], []
    for g, (window, dilation) in enumerate(DILATED_GROUPS):
        sl = slice(g * GROUP_WIDTH, (g + 1) * GROUP_WIDTH)
        qg, kg, vg = (t[..., sl].reshape(B, S, ATTN_HEADS_PER_GROUP, HEAD_DIM) for t in (q, k, v))
        o, lse = dilated_window_attention(qg, kg, vg, window, dilation)
        outs.append(o.astype(jnp.float32))
        lses.append(lse)
    weights = jax.nn.softmax(jnp.stack(lses), axis=0)
    out = jnp.einsum('gbsh,gbshd->bshd', weights, jnp.stack(outs))
    return out.reshape(B, S, ATTN_OUT_WIDTH).astype(q.dtype)


def hgrn2_branch(q, f_logit, i, g_out, lower_bound, norm_gain):
    B, S, _ = q.shape
    H, K, V, C = HGRN_HEADS, HGRN_KEY_DIM, HGRN_VAL_DIM, HGRN_CHUNK
    N = S // C
    dt = q.dtype
    lb = lower_bound.astype(jnp.float32)
    fl = f_logit.astype(jnp.float32)
    log_f = jnp.log(lb + (1.0 - lb) * jax.nn.sigmoid(fl))
    key = (1.0 - lb) * jax.nn.sigmoid(-fl)
    qf = jax.nn.silu(q.astype(jnp.float32))
    vf = i.astype(jnp.float32)

    def chunked(t, w):
        return t.reshape(B, N, C, H, w).transpose(1, 0, 3, 2, 4)

    causal = jnp.tril(jnp.ones((C, C), dtype=bool))

    def step(state, inp):
        qc, kc, vc, lfc = inp
        b = jnp.cumsum(lfc, axis=2)
        o_inter = jnp.einsum('bhtk,bhkv->bhtv', qc * jnp.exp(b), state)
        diff = b[:, :, :, None, :] - b[:, :, None, :, :]
        decay = jnp.exp(jnp.where(causal[:, :, None], diff, MASK_VALUE))
        scores = jnp.einsum('bhtk,bhsk,bhtsk->bhts', qc, kc, decay)
        o = o_inter + jnp.einsum('bhts,bhsv->bhtv', scores, vc)
        b_last = b[:, :, -1:, :]
        state = (jnp.exp(b_last[:, :, 0, :])[..., None] * state
                 + jnp.einsum('bhsk,bhsv->bhkv', kc * jnp.exp(b_last - b), vc))
        return state, o

    s0 = jnp.zeros((B, H, K, V), jnp.float32)
    _, o = lax.scan(step, s0, (chunked(qf, K), chunked(key, K), chunked(vf, V), chunked(log_f, K)))
    o = o.transpose(1, 0, 3, 2, 4).reshape(B, S, H, V)
    o = o * lax.rsqrt(jnp.mean(o * o, axis=-1, keepdims=True) + EPS) * norm_gain.astype(jnp.float32)
    o = o.reshape(B, S, H * V) * jax.nn.silu(g_out.astype(jnp.float32))
    return o.astype(dt)


def setup_inputs(seed: int = 0) -> dict:
    key = jax.random.key(seed)
    ks = jax.random.split(key, 14)
    nrm = lambda k, shape, fan_in: jax.random.normal(k, shape, jnp.float32) * (fan_in ** -0.5)
    gain = lambda k, shape: 1.0 + 0.02 * jax.random.normal(k, shape, jnp.float32)
    HV = HGRN_HEADS * HGRN_VAL_DIM
    return {
        "x": jax.random.normal(ks[0], (BATCH, SEQ, D_MODEL), jnp.float32),
        "ffn_norm": gain(ks[1], (DEPTH, 2, D_MODEL)),
        "ffn_w_in": nrm(ks[2], (DEPTH, 2, D_MODEL, 2 * D_FF), D_MODEL),
        "ffn_w_out": nrm(ks[3], (DEPTH, 2, D_FF, D_MODEL), D_FF),
        "mix_norm": gain(ks[4], (DEPTH, D_MODEL)),
        "w_in": nrm(ks[5], (DEPTH, D_MODEL, IN_WIDTH), D_MODEL),
        "b_gate": 0.01 * jax.random.normal(ks[6], (DEPTH, 2 * D_MODEL), jnp.float32),
        "hgrn_lb": 1.0 + 0.1 * jax.random.normal(ks[7], (DEPTH, HGRN_WIDTH), jnp.float32),
        "hgrn_norm": gain(ks[8], (DEPTH, HGRN_VAL_DIM)),
        "w_proj_attn": nrm(ks[9], (DEPTH, ATTN_OUT_WIDTH, D_MODEL), ATTN_OUT_WIDTH),
        "w_proj_hgrn": nrm(ks[10], (DEPTH, HV, D_MODEL), HV),
        "w_out": nrm(ks[11], (DEPTH, D_MODEL, D_MODEL), D_MODEL),
        "final_norm": gain(ks[12], (D_MODEL,)),
    }


def reference(x, ffn_norm, ffn_w_in, ffn_w_out, mix_norm, w_in, b_gate, hgrn_lb, hgrn_norm,
              w_proj_attn, w_proj_hgrn, w_out, final_norm):
    p = jax.nn.softmax(hgrn_lb.astype(jnp.float32), axis=0)
    lower_bounds = jnp.cumsum(p, axis=0) - p[0:1]
    split_idx = np.cumsum(SPLIT_SIZES)[:-1].tolist()
    for l in range(DEPTH):
        x = x + MACARON_WEIGHT * swiglu(rms_norm(x, ffn_norm[l, 0]), ffn_w_in[l, 0], ffn_w_out[l, 0])
        h = rms_norm(x, mix_norm[l])
        z = h @ w_in[l]
        q_a, k_a, v_a, q_h, f_h, i_h, g_h, gate_logits = jnp.split(z, split_idx, axis=-1)
        a = dilated_attention_branch(q_a, k_a, v_a) @ w_proj_attn[l]
        m = hgrn2_branch(q_h, f_h, i_h, g_h, lower_bounds[l], hgrn_norm[l]) @ w_proj_hgrn[l]
        gate_a, gate_m = jnp.split(jax.nn.sigmoid(gate_logits + b_gate[l]), 2, axis=-1)
        x = x + (gate_a * a + gate_m * m) @ w_out[l]
        x = x + MACARON_WEIGHT * swiglu(rms_norm(x, ffn_norm[l, 1]), ffn_w_in[l, 1], ffn_w_out[l, 1])
    return rms_norm(x, final_norm)
```

```cpp
#include <hip/hip_runtime.h>
#include <cstdio>
#include <cstdint>
namespace pg8 {
#define PG8_LAS __attribute__((address_space(3)))
typedef unsigned short bf16_t;
typedef short bf16x8 __attribute__((ext_vector_type(8)));
typedef float f32x4 __attribute__((ext_vector_type(4)));
typedef unsigned u32x4 __attribute__((ext_vector_type(4)));
constexpr int BM = 256, BK = 64, HALF = 128, HTB = HALF * BK * 2  , STAGE_BYTES = 8 * HTB, NXCD = 8, WGM = 8;

__host__ __device__ __forceinline__ int lds_byte(int r, int c) { const int st = (r >> 4) * 2 + (c >> 5), rr = r & 15, cc = c & 31, ob = rr * 64 + cc * 2; return st * 1024 + (ob ^ (((ob >> 9) & 1) << 5)); }
__host__ __device__ __forceinline__ void stage_rc(int b, int& R, int& C) { const int st = b / 1024, sb = b % 1024, swz = sb ^ (((sb >> 9) & 1) << 5); R = (st >> 1) * 16 + swz / 64; C = (st & 1) * 32 + (swz % 64) / 2; }
__host__ __device__ __forceinline__ int perm32(int rho) { const int n = rho >> 4, i = rho & 15; return 8 * (i >> 2) + 4 * n + (i & 3); }

struct Unit { int pm, pn; };
struct Gemm { const bf16_t* A; const bf16_t* Bt; int M, N, K; };

struct StaticOrder {
    int nM, nN, nwg, G, c;
    __host__ __device__ void init(int M, int N, int G_, int c_) { nM = M / BM; nN = N / BM; nwg = nM * nN; G = G_; c = c_; }
    __host__ __device__ bool next(int i, Unit& u) const {
        const long L = (long)i * G + c; if (L >= nwg) return false;
        int wgid = (int)L; { const int q = nwg / NXCD, r = nwg % NXCD, xcd = wgid % NXCD, off = wgid / NXCD; wgid = (xcd < r ? xcd * (q + 1) : r * (q + 1) + (xcd - r) * q) + off; }
        const int nig = WGM * nN, gid = wgid / nig, fm = gid * WGM, gsz = (nM - fm) < WGM ? (nM - fm) : WGM;
        u.pm = fm + ((wgid % nig) % gsz); u.pn = (wgid % nig) / gsz; return true;
    }
    __device__ __forceinline__ void a_ready(const Unit&) const {}
    __device__ __forceinline__ void done(const Unit&) const {}
};
__device__ __forceinline__ unsigned cvt_pk_bf16(float lo, float hi) { unsigned r; asm volatile("v_cvt_pk_bf16_f32 %0, %1, %2" : "=v"(r) : "v"(lo), "v"(hi)); return r; }
constexpr float RMS_EPS = 1e-6f;
constexpr int DM = 2048, DFF = 5504, INW = 12800;
typedef unsigned long long ss_t;
__device__ __forceinline__ ss_t ss_fix(float ss) { return (ss_t)(ss * 4294967296.0f); }
__device__ __forceinline__ float rstd_of(ss_t ss) { return __builtin_amdgcn_rsqf((float)ss * (1.0f / 4294967296.0f / 2048.0f) + RMS_EPS); }
__device__ __forceinline__ float sigmoid_f(float x) { return __builtin_amdgcn_rcpf(1.0f + __expf(-x)); }
__device__ __forceinline__ float silu_f(float x) { return x * sigmoid_f(x); }
__device__ __forceinline__ float bflo(unsigned w) { return __uint_as_float(w << 16); }
__device__ __forceinline__ float bfhi(unsigned w) { return __uint_as_float(w & 0xffff0000u); }

struct EpiFfnUp {
    static constexpr bool PERM = true, AFTER_DRAIN = false;
    bf16_t* H; const ss_t* rowss;
    __device__ __forceinline__ void operator()(const f32x4 (&acc)[2][2][4][2], const Unit& u, int wr, int wc, int fr, int fq) const {
        const int row0 = u.pm * BM + wr * 64 + fr, col0 = u.pn * 128 + wc * 32 + 8 * fq;
#pragma unroll
        for (int ai = 0; ai < 2; ++ai)
#pragma unroll
            for (int m = 0; m < 4; ++m) {
                const int row = row0 + ai * HALF + m * 16; const float rs = rstd_of(rowss[row]);
                float h[8];
#pragma unroll
                for (int n = 0; n < 2; ++n)
#pragma unroll
                    for (int j = 0; j < 4; ++j) { const float g = rs * acc[ai][0][m][n][j], up = rs * acc[ai][1][m][n][j]; h[4 * n + j] = silu_f(g) * up; }
                u32x4 w; w.x = cvt_pk_bf16(h[0], h[1]); w.y = cvt_pk_bf16(h[2], h[3]); w.z = cvt_pk_bf16(h[4], h[5]); w.w = cvt_pk_bf16(h[6], h[7]);
                *(u32x4*)(H + (size_t)row * DFF + col0) = w;
            }
    }
};
struct EpiResid {
    static constexpr bool PERM = true, AFTER_DRAIN = false;
    float* X; bf16_t* XB; ss_t* rowss_out; float scale;
    __device__ __forceinline__ void operator()(const f32x4 (&acc)[2][2][4][2], const Unit& u, int wr, int wc, int fr, int fq) const {
        const int row0 = u.pm * BM + wr * 64 + fr, col0 = u.pn * BM + wc * 32 + 8 * fq;
#pragma unroll
        for (int ai = 0; ai < 2; ++ai)
#pragma unroll
            for (int m = 0; m < 4; ++m) {
                const int row = row0 + ai * HALF + m * 16; float ss = 0.f;
#pragma unroll
                for (int bj = 0; bj < 2; ++bj) {
                    float* xp = X + (size_t)row * DM + col0 + bj * HALF;
                    f32x4 x0 = *(const f32x4*)xp, x1 = *(const f32x4*)(xp + 4);
                    x0 = x0 + acc[ai][bj][m][0] * scale; x1 = x1 + acc[ai][bj][m][1] * scale;
                    *(f32x4*)xp = x0; *(f32x4*)(xp + 4) = x1;
                    u32x4 w; w.x = cvt_pk_bf16(x0[0], x0[1]); w.y = cvt_pk_bf16(x0[2], x0[3]); w.z = cvt_pk_bf16(x1[0], x1[1]); w.w = cvt_pk_bf16(x1[2], x1[3]);
                    *(u32x4*)(XB + (size_t)row * DM + col0 + bj * HALF) = w;
                    ss += (x0[0] * x0[0] + x0[1] * x0[1]) + (x0[2] * x0[2] + x0[3] * x0[3]) + (x1[0] * x1[0] + x1[1] * x1[1]) + (x1[2] * x1[2] + x1[3] * x1[3]);
                }
                ss += __shfl_xor(ss, 16); ss += __shfl_xor(ss, 32);
                if (fq == 0) __hip_atomic_fetch_add(rowss_out + row, ss_fix(ss), __ATOMIC_RELAXED, __HIP_MEMORY_SCOPE_AGENT);
            }
    }
};
constexpr float QSCALE = 0.08838834764831845f * 1.4426950408889634f;
constexpr int ZC_QA = 0, ZC_KA = 1536, ZC_VA = 3072, ZC_QH = 4608, ZC_FH = 5632, ZC_IH = 6656, ZC_GH = 7680, ZC_GA = 8704, ZC_GM = 10752;
struct EpiZ {
    static constexpr bool PERM = true, AFTER_DRAIN = false;
    bf16_t* Z; float* LOGF; const ss_t* rowss; const float* lb; const float* bgate;
    __device__ __forceinline__ void operator()(const f32x4 (&acc)[2][2][4][2], const Unit& u, int wr, int wc, int fr, int fq) const {
        const int pn = u.pn;
        const int mode = pn < 6 ? 0 : pn < 18 ? 1 : pn < 22 ? 2 : pn < 26 ? 3 : pn < 30 ? 1 : pn < 34 ? 2 : 4;
        const int row0 = u.pm * BM + wr * 64 + fr, colb = pn * BM + wc * 32 + 8 * fq;
        float par[2][8];
#pragma unroll
        for (int bj = 0; bj < 2; ++bj) {
            f32x4 p0 = (f32x4){0.f, 0.f, 0.f, 0.f}, p1 = p0;
            if (mode == 3) { const float* p = lb + (colb + bj * HALF - ZC_FH); p0 = *(const f32x4*)p; p1 = *(const f32x4*)(p + 4); }
            if (mode == 4) { const float* p = bgate + (colb + bj * HALF - ZC_GA); p0 = *(const f32x4*)p; p1 = *(const f32x4*)(p + 4); }
#pragma unroll
            for (int j = 0; j < 4; ++j) { par[bj][j] = p0[j]; par[bj][4 + j] = p1[j]; }
        }
#pragma unroll
        for (int ai = 0; ai < 2; ++ai)
#pragma unroll
            for (int m = 0; m < 4; ++m) {
                const int row = row0 + ai * HALF + m * 16; const float rs = rstd_of(rowss[row]);
#pragma unroll
                for (int bj = 0; bj < 2; ++bj) {
                    float v[8];
#pragma unroll
                    for (int n = 0; n < 2; ++n)
#pragma unroll
                        for (int j = 0; j < 4; ++j) v[4 * n + j] = rs * acc[ai][bj][m][n][j];
                    if (mode == 0) {
#pragma unroll
                        for (int j = 0; j < 8; ++j) v[j] *= QSCALE;
                    } else if (mode == 2) {
#pragma unroll
                        for (int j = 0; j < 8; ++j) v[j] = silu_f(v[j]);
                    } else if (mode == 4) {
#pragma unroll
                        for (int j = 0; j < 8; ++j) v[j] = sigmoid_f(v[j] + par[bj][j]);
                    } else if (mode == 3) {
                        float lg[8];
#pragma unroll
                        for (int j = 0; j < 8; ++j) { const float l = par[bj][j], fl = v[j]; const float sg = sigmoid_f(fl); lg[j] = __logf(l + (1.0f - l) * sg); v[j] = (1.0f - l) * __builtin_amdgcn_rcpf(1.0f + __expf(fl)); }
                        float* lp = LOGF + (size_t)row * 1024 + (colb + bj * HALF - ZC_FH);
                        *(f32x4*)lp = (f32x4){lg[0], lg[1], lg[2], lg[3]}; *(f32x4*)(lp + 4) = (f32x4){lg[4], lg[5], lg[6], lg[7]};
                    }
                    u32x4 w; w.x = cvt_pk_bf16(v[0], v[1]); w.y = cvt_pk_bf16(v[2], v[3]); w.z = cvt_pk_bf16(v[4], v[5]); w.w = cvt_pk_bf16(v[6], v[7]);
                    *(u32x4*)(Z + (size_t)row * INW + colb + bj * HALF) = w;
                }
            }
    }
};
struct EpiPa {
    static constexpr bool PERM = true, AFTER_DRAIN = false;
    const bf16_t* Z; float* Y32;
    __device__ __forceinline__ void operator()(const f32x4 (&acc)[2][2][4][2], const Unit& u, int wr, int wc, int fr, int fq) const {
        const int row0 = u.pm * BM + wr * 64 + fr, col0 = u.pn * BM + wc * 32 + 8 * fq;
#pragma unroll
        for (int ai = 0; ai < 2; ++ai)
#pragma unroll
            for (int m = 0; m < 4; ++m) {
                const int row = row0 + ai * HALF + m * 16;
#pragma unroll
                for (int bj = 0; bj < 2; ++bj) {
                    const u32x4 g = *(const u32x4*)(Z + (size_t)row * INW + ZC_GA + col0 + bj * HALF);
                    const f32x4 a0 = acc[ai][bj][m][0], a1 = acc[ai][bj][m][1];
                    float* yp = Y32 + (size_t)row * DM + col0 + bj * HALF;
                    *(f32x4*)yp = (f32x4){bflo(g.x) * a0[0], bfhi(g.x) * a0[1], bflo(g.y) * a0[2], bfhi(g.y) * a0[3]};
                    *(f32x4*)(yp + 4) = (f32x4){bflo(g.z) * a1[0], bfhi(g.z) * a1[1], bflo(g.w) * a1[2], bfhi(g.w) * a1[3]};
                }
            }
    }
};
struct EpiPm {
    static constexpr bool PERM = true, AFTER_DRAIN = false;
    const bf16_t* Z; const float* Y32; bf16_t* YB;
    __device__ __forceinline__ void operator()(const f32x4 (&acc)[2][2][4][2], const Unit& u, int wr, int wc, int fr, int fq) const {
        const int row0 = u.pm * BM + wr * 64 + fr, col0 = u.pn * BM + wc * 32 + 8 * fq;
#pragma unroll
        for (int ai = 0; ai < 2; ++ai)
#pragma unroll
            for (int m = 0; m < 4; ++m) {
                const int row = row0 + ai * HALF + m * 16;
#pragma unroll
                for (int bj = 0; bj < 2; ++bj) {
                    const u32x4 g = *(const u32x4*)(Z + (size_t)row * INW + ZC_GM + col0 + bj * HALF);
                    const f32x4 a0 = acc[ai][bj][m][0], a1 = acc[ai][bj][m][1];
                    const float* yp = Y32 + (size_t)row * DM + col0 + bj * HALF;
                    const f32x4 y0 = *(const f32x4*)yp, y1 = *(const f32x4*)(yp + 4);
                    u32x4 w;
                    w.x = cvt_pk_bf16(y0[0] + bflo(g.x) * a0[0], y0[1] + bfhi(g.x) * a0[1]); w.y = cvt_pk_bf16(y0[2] + bflo(g.y) * a0[2], y0[3] + bfhi(g.y) * a0[3]);
                    w.z = cvt_pk_bf16(y1[0] + bflo(g.z) * a1[0], y1[1] + bfhi(g.z) * a1[1]); w.w = cvt_pk_bf16(y1[2] + bflo(g.w) * a1[2], y1[3] + bfhi(g.w) * a1[3]);
                    *(u32x4*)(YB + (size_t)row * DM + col0 + bj * HALF) = w;
                }
            }
    }
};
template <class Epi, class Sched, bool ALIGN_EPI = false, bool SP2 = false>
__device__ __forceinline__ void gemm_phase(PG8_LAS unsigned char* lds, const Gemm g, const Sched& S, const Epi& E) {
    int tid_l = threadIdx.x; asm volatile("" : "+v"(tid_l));
    const int tid = tid_l, wid = __builtin_amdgcn_readfirstlane(tid >> 6), lane = tid & 63, wr = wid >> 2, wc = wid & 3, fr = lane & 15, fq = lane >> 4;
    const int K = g.K, nt = K / BK;
    unsigned voffA[2], voffB[2];
#pragma unroll
    for (int i = 0; i < 2; ++i) { int R, C; stage_rc(tid * 16 + i * 8192, R, C); const int Rb = Epi::PERM ? ((R & ~31) + perm32(R & 31)) : R;
        voffA[i] = (unsigned)(R * K + C) * 2u; voffB[i] = (unsigned)(Rb * K + C) * 2u; }
    const size_t kstep = (size_t)(BK * 2);
    const size_t hstep = (size_t)HALF * K * 2;
    const size_t tstep = 2 * hstep;
    const unsigned ldsw = (unsigned)wid * 1024u;
    const int aoff = lds_byte(wr * 64 + fr, fq * 8), boff = lds_byte(wc * 32 + fr, fq * 8);
#define PG8_SA(b, h) (((b) * 2 + (h)) * HTB)
#define PG8_SB(b, h) ((4 + (b) * 2 + (h)) * HTB)
#define PG8_STAGE(bufoff, gbase, voff) do { _Pragma("unroll") for (int _i = 0; _i < 2; ++_i) \
        __builtin_amdgcn_global_load_lds((const unsigned*)((const char*)(gbase) + (voff)[_i]), (PG8_LAS unsigned*)(lds + (bufoff) + ldsw + _i * 8192), 16, 0, 0); } while (0)
#define PG8_LDA(dst, b, h) do { _Pragma("unroll") for (int m = 0; m < 4; ++m) _Pragma("unroll") for (int k = 0; k < 2; ++k) dst[m][k] = *(const PG8_LAS bf16x8*)(lds + PG8_SA(b, h) + aoff + m * 2048 + k * 1024); } while (0)
#define PG8_LDB(dst, b, h) do { _Pragma("unroll") for (int n = 0; n < 2; ++n) _Pragma("unroll") for (int k = 0; k < 2; ++k) dst[n][k] = *(const PG8_LAS bf16x8*)(lds + PG8_SB(b, h) + boff + n * 2048 + k * 1024); } while (0)
#define PG8_MMA(ai, bj, At, Bt) do { __builtin_amdgcn_s_setprio(1); _Pragma("unroll") for (int m = 0; m < 4; ++m) _Pragma("unroll") for (int n = 0; n < 2; ++n) _Pragma("unroll") for (int k = 0; k < 2; ++k) \
        acc[ai][bj][m][n] = __builtin_amdgcn_mfma_f32_16x16x32_bf16(Bt[n][k], At[m][k], acc[ai][bj][m][n], 0, 0, 0); __builtin_amdgcn_s_setprio(0); } while (0)
#define PG8_WAIT_V(n) asm volatile("s_waitcnt vmcnt(" #n ")" ::: "memory")
#define PG8_WAIT_L(n) asm volatile("s_waitcnt lgkmcnt(" #n ")" ::: "memory")
#define PG8_BAR __builtin_amdgcn_s_barrier()
#define PG8_SCHED __builtin_amdgcn_sched_barrier(0)
    Unit cur, nxt; int ui = 0;
    if (!S.next(0, cur)) return;
    f32x4 acc[2][2][4][2];
#pragma unroll
    for (int a = 0; a < 2; ++a)
#pragma unroll
        for (int b = 0; b < 2; ++b)
#pragma unroll
            for (int m = 0; m < 4; ++m)
#pragma unroll
                for (int n = 0; n < 2; ++n) acc[a][b][m][n] = (f32x4){0.f, 0.f, 0.f, 0.f};
    bf16x8 At[4][2], B0[2][2], B1[2][2];
    const char* cA = (const char*)g.A + (size_t)cur.pm * tstep; const char* cB = (const char*)g.Bt + (size_t)cur.pn * tstep;
    S.a_ready(cur);
    if constexpr (SP2) {
        PG8_STAGE(PG8_SB(0, 0), cB, voffB); PG8_STAGE(PG8_SB(0, 1), cB + hstep, voffB); PG8_STAGE(PG8_SA(0, 0), cA, voffA); PG8_STAGE(PG8_SA(0, 1), cA + hstep, voffA);
        if (wr == 1) PG8_BAR;
        PG8_WAIT_V(2); PG8_BAR;
        PG8_STAGE(PG8_SB(1, 0), cB + kstep, voffB); PG8_STAGE(PG8_SA(1, 0), cA + kstep, voffA); PG8_STAGE(PG8_SB(1, 1), cB + hstep + kstep, voffB);
        PG8_WAIT_V(6); PG8_BAR;
    } else {
        PG8_STAGE(PG8_SB(0, 0), cB, voffB); PG8_STAGE(PG8_SA(0, 0), cA, voffA); PG8_STAGE(PG8_SB(0, 1), cB + hstep, voffB); PG8_STAGE(PG8_SA(0, 1), cA + hstep, voffA);
        if (wr == 1) PG8_BAR;
        PG8_WAIT_V(4); PG8_BAR;
        PG8_STAGE(PG8_SB(1, 0), cB + kstep, voffB); PG8_STAGE(PG8_SA(1, 0), cA + kstep, voffA); PG8_STAGE(PG8_SB(1, 1), cB + hstep + kstep, voffB);
        PG8_WAIT_V(6); PG8_BAR;
    }
    for (;;) {
        const bool has_next = S.next(ui + 1, nxt);
        const char* nA = has_next ? (const char*)g.A + (size_t)nxt.pm * tstep : cA; const char* nB = has_next ? (const char*)g.Bt + (size_t)nxt.pn * tstep : cB;
        for (int t = 0; t < nt; t += 2) {
            const bool last = (t == nt - 2);
            const char* a1 = cA + (size_t)(t + 1) * kstep;
            const char* a2 = last ? nA : cA + (size_t)(t + 2) * kstep; const char* b2 = last ? nB : cB + (size_t)(t + 2) * kstep;
            const char* a3 = a2 + kstep; const char* b3 = b2 + kstep;
            if (last && has_next) S.a_ready(nxt);
            if constexpr (SP2) {
            PG8_LDB(B0, 0, 0); PG8_LDB(B1, 0, 1); PG8_SCHED; PG8_LDA(At, 0, 0); PG8_STAGE(PG8_SA(1, 1), a1 + hstep, voffA);
            PG8_WAIT_V(8); PG8_WAIT_L(0); PG8_BAR; PG8_MMA(0, 0, At, B0); PG8_MMA(0, 1, At, B1); PG8_BAR; PG8_SCHED;
            PG8_LDA(At, 0, 1); PG8_STAGE(PG8_SB(0, 0), b2, voffB); PG8_STAGE(PG8_SB(0, 1), b2 + hstep, voffB); PG8_STAGE(PG8_SA(0, 0), a2, voffA);
            PG8_WAIT_V(8); PG8_WAIT_L(0); PG8_BAR; PG8_MMA(1, 0, At, B0); PG8_MMA(1, 1, At, B1); PG8_BAR; PG8_SCHED;
            PG8_LDB(B0, 1, 0); PG8_LDB(B1, 1, 1); PG8_SCHED; PG8_LDA(At, 1, 0); PG8_STAGE(PG8_SA(0, 1), a2 + hstep, voffA);
            PG8_WAIT_V(8); PG8_WAIT_L(0); PG8_BAR; PG8_MMA(0, 0, At, B0); PG8_MMA(0, 1, At, B1); PG8_BAR; PG8_SCHED;
            PG8_LDA(At, 1, 1); PG8_STAGE(PG8_SB(1, 0), b3, voffB); PG8_STAGE(PG8_SB(1, 1), b3 + hstep, voffB); PG8_STAGE(PG8_SA(1, 0), a3, voffA);
            PG8_WAIT_V(8); PG8_WAIT_L(0); PG8_BAR; PG8_MMA(1, 0, At, B0); PG8_MMA(1, 1, At, B1); PG8_BAR; PG8_SCHED;
            } else {
            PG8_LDB(B0, 0, 0); PG8_SCHED; PG8_LDA(At, 0, 0); PG8_STAGE(PG8_SA(1, 1), a1 + hstep, voffA);
            PG8_WAIT_L(8); PG8_BAR; PG8_WAIT_L(0); PG8_MMA(0, 0, At, B0); PG8_BAR; PG8_SCHED;
            PG8_LDB(B1, 0, 1); PG8_STAGE(PG8_SB(0, 0), b2, voffB);
            PG8_BAR; PG8_WAIT_L(0); PG8_MMA(0, 1, At, B1); PG8_BAR;
            PG8_LDA(At, 0, 1); PG8_STAGE(PG8_SA(0, 0), a2, voffA);
            PG8_BAR; PG8_WAIT_L(0); PG8_MMA(1, 0, At, B0); PG8_BAR; PG8_SCHED;
            PG8_STAGE(PG8_SB(0, 1), b2 + hstep, voffB);
            PG8_WAIT_V(6); PG8_BAR; PG8_MMA(1, 1, At, B1); PG8_BAR;
            PG8_LDB(B0, 1, 0); PG8_SCHED; PG8_LDA(At, 1, 0); PG8_STAGE(PG8_SA(0, 1), a2 + hstep, voffA);
            PG8_WAIT_L(8); PG8_BAR; PG8_WAIT_L(0); PG8_MMA(0, 0, At, B0); PG8_BAR; PG8_SCHED;
            PG8_LDB(B1, 1, 1); PG8_STAGE(PG8_SB(1, 0), b3, voffB);
            PG8_BAR; PG8_WAIT_L(0); PG8_MMA(0, 1, At, B1); PG8_BAR;
            PG8_LDA(At, 1, 1); PG8_STAGE(PG8_SA(1, 0), a3, voffA);
            PG8_BAR; PG8_WAIT_L(0); PG8_MMA(1, 0, At, B0); PG8_BAR; PG8_SCHED;
            PG8_STAGE(PG8_SB(1, 1), b3 + hstep, voffB);
            PG8_WAIT_V(6); PG8_BAR; PG8_MMA(1, 1, At, B1); PG8_BAR;
            }
        }
        if constexpr (ALIGN_EPI) { if (wr == 0) PG8_BAR; }
        if constexpr (!Epi::AFTER_DRAIN) { E(acc, cur, wr, wc, fr, fq); S.done(cur); }
        if (!has_next) break;
#pragma unroll
        for (int a = 0; a < 2; ++a)
#pragma unroll
            for (int b = 0; b < 2; ++b)
#pragma unroll
                for (int m = 0; m < 4; ++m)
#pragma unroll
                    for (int n = 0; n < 2; ++n) acc[a][b][m][n] = (f32x4){0.f, 0.f, 0.f, 0.f};
        cur = nxt; cA = nA; cB = nB; ++ui;
        if constexpr (ALIGN_EPI) { if (wr == 1) PG8_BAR; }
    }
    PG8_WAIT_V(0);
    if constexpr (!ALIGN_EPI) { if (wr == 0) PG8_BAR; }
    PG8_BAR;
    if constexpr (Epi::AFTER_DRAIN) { E.fused(acc, cur, wr, wc, fr, fq, lds, wid, lane); S.done(cur); }
#undef PG8_SA
#undef PG8_SB
#undef PG8_STAGE
#undef PG8_LDA
#undef PG8_LDB
#undef PG8_MMA
#undef PG8_WAIT_V
#undef PG8_WAIT_L
#undef PG8_BAR
#undef PG8_SCHED
}
}
#define GAS __attribute__((address_space(1)))
#define LAS __attribute__((address_space(3)))
typedef unsigned short bf16;
typedef unsigned v4u __attribute__((ext_vector_type(4)));
typedef float f32x4 __attribute__((ext_vector_type(4)));
typedef short bf16x8 __attribute__((ext_vector_type(8)));
typedef GAS unsigned gu32;
typedef GAS unsigned long long gu64;
#define RLX_AGENT __ATOMIC_RELAXED, __HIP_MEMORY_SCOPE_AGENT
#define LDS_WAIT() asm volatile("s_waitcnt lgkmcnt(0)" ::: "memory")
#define VM_WAIT() asm volatile("s_waitcnt vmcnt(0)" ::: "memory")
__device__ __forceinline__ unsigned long long rt() { return __builtin_amdgcn_s_memrealtime(); }
__device__ __forceinline__ unsigned f2bf(float f) { unsigned u = __builtin_bit_cast(unsigned, f); return (u + 0x7fffu + ((u >> 16) & 1u)) >> 16; }
__device__ __forceinline__ unsigned pk2(float lo, float hi) { return pg8::cvt_pk_bf16(lo, hi); }

#define XB_TMO      128
#define XB_XCNT(j)  (256  + 64 * (j))
#define XB_XSUB(j)  (1280 + 64 * (j))
#define XB_XGEN(j)  (2304 + 64 * (j))
#define XB_TOP      3328
#define XB_TOPGEN   3392
#define XCD_BAR_WORDS 3456
#define XB_SPIN_CAP (1u << 18)

__device__ __forceinline__ unsigned xb_ld(unsigned* p)              { return __hip_atomic_load(p, __ATOMIC_RELAXED, __HIP_MEMORY_SCOPE_AGENT); }
__device__ __forceinline__ unsigned xb_add(unsigned* p, unsigned v) { return __hip_atomic_fetch_add(p, v, __ATOMIC_RELAXED, __HIP_MEMORY_SCOPE_AGENT); }
__device__ __forceinline__ unsigned xb_xcc_id() { return (unsigned)__builtin_amdgcn_s_getreg((3 << 11) | 20) & 0xFu; }
#define XB_SPIN(cond, bar) do { unsigned _sp = 0; while (cond) { __builtin_amdgcn_s_sleep(1); \
    if ((++_sp & 255u) == 0u) { if (xb_ld(&(bar)[XB_TMO])) break; if (_sp > XB_SPIN_CAP) { atomicAdd(&(bar)[XB_TMO], 1u); break; } } } } while (0)

struct XcdBarrier {
    unsigned* bar; unsigned x;
    volatile LAS unsigned* st;
};

__device__ __forceinline__ XcdBarrier xcd_barrier_post(unsigned* bar, volatile LAS unsigned* st) {
    XcdBarrier b; b.bar = bar; b.x = xb_xcc_id(); b.st = st;
    if (threadIdx.x == 0) (void)xb_add(&bar[XB_XCNT(b.x)], 1u);
    return b;
}
__device__ __forceinline__ void xcd_barrier_complete(unsigned* bar, unsigned x, unsigned& nloc, unsigned& nx) {
    const unsigned G = gridDim.x * gridDim.y * gridDim.z;
    unsigned sum, cnt, mine, sp = 0u;
    for (;;) {
        sum = 0u; cnt = 0u; mine = 0u;
#pragma unroll
        for (unsigned j = 0; j < 16; ++j) { const unsigned c = xb_ld(&bar[XB_XCNT(j)]); sum += c; cnt += (c > 0u) ? 1u : 0u; mine = (j == x) ? c : mine; }
        if (sum == G) break;
        __builtin_amdgcn_s_sleep(1);
        if ((++sp & 255u) == 0u) { if (xb_ld(&bar[XB_TMO])) break; if (sp > XB_SPIN_CAP) { atomicAdd(&bar[XB_TMO], 1u); break; } }
    }
    nloc = mine > 0u ? mine : 1u; nx = cnt > 0u ? cnt : 1u;
}

__device__ __forceinline__ void xcd_barrier(const XcdBarrier& b) {
    asm volatile("s_waitcnt vmcnt(0)" ::: "memory");
    __syncthreads();
    if (threadIdx.x == 0) {
        unsigned* bar = b.bar;
        __builtin_amdgcn_s_waitcnt(0);
        unsigned nloc = b.st[0], nx = b.st[1];
        if (nloc == 0u) { xcd_barrier_complete(bar, b.x, nloc, nx); b.st[0] = nloc; b.st[1] = nx; }
        const unsigned old = xb_add(&bar[XB_XSUB(b.x)], 1u);
        const unsigned gen = old / nloc;
        if (old + 1u == (gen + 1u) * nloc) {
            __builtin_amdgcn_fence(__ATOMIC_RELEASE, "agent");
            asm volatile("s_waitcnt vmcnt(0)" ::: "memory");
            const unsigned og = xb_add(&bar[XB_TOP], 1u);
            const unsigned tg = og / nx;
            if (og + 1u == (tg + 1u) * nx) xb_add(&bar[XB_TOPGEN], 1u);
            else XB_SPIN(xb_ld(&bar[XB_TOPGEN]) == tg, bar);
            __builtin_amdgcn_fence(__ATOMIC_ACQUIRE, "agent");
            xb_add(&bar[XB_XGEN(b.x)], 1u);
            asm volatile("s_waitcnt vmcnt(0)" ::: "memory");
        } else {
            XB_SPIN(xb_ld(&bar[XB_XGEN(b.x)]) == gen, bar);
            __builtin_amdgcn_fence(__ATOMIC_ACQUIRE, "agent");
            asm volatile("s_waitcnt vmcnt(0)" ::: "memory");
        }
    }
    __syncthreads();
}

constexpr int NWAVES = 8;
constexpr int BATCH = 8, SEQ = 2048, M = BATCH * SEQ, DEPTH = 4;
constexpr int DM = pg8::DM, DFF = pg8::DFF, NUP = 2 * DFF, INW = pg8::INW;
constexpr int AW = 512, HW = 1024;
using pg8::ZC_QA; using pg8::ZC_KA; using pg8::ZC_VA; using pg8::ZC_QH; using pg8::ZC_FH; using pg8::ZC_IH; using pg8::ZC_GH;
constexpr float RMS_EPS = 1e-6f;
#ifndef MK_ONE_LAUNCH
#define MK_ONE_LAUNCH 0
#endif
constexpr int N_PHASES = 1 + 8 * 2 + 4 * 5 + 1;

constexpr size_t MiB = 1u << 20;
constexpr size_t WS_CTL = 0, CTL_ZERO_BYTES = 4 * MiB;
constexpr size_t WS_ROWSS = 2 * MiB;
constexpr size_t WS_LB = 4 * MiB;
constexpr size_t WS_X = 16 * MiB;
constexpr size_t WS_XB = 144 * MiB;
constexpr size_t WS_HFF = 208 * MiB;
constexpr size_t WS_Z = 384 * MiB;
constexpr size_t WS_LOGF = 784 * MiB;
constexpr size_t WS_ATT = 848 * MiB;
constexpr size_t WS_HG = 864 * MiB;
constexpr size_t WS_Y32 = 896 * MiB;
constexpr size_t WS_YB = 1024 * MiB;
constexpr size_t WS_O32 = 1088 * MiB;
constexpr size_t WS_W = 1300 * MiB;
constexpr size_t WL_BYTES = 193 * MiB;
constexpr size_t WO_W1 = 0, W1_BYTES = 43 * MiB, WO_W2 = 86 * MiB, W2_BYTES = (size_t)DM * DFF * 2, WO_WIN = 129 * MiB, WO_WPA = 179 * MiB, WO_WPM = 181 * MiB, WO_WO = 185 * MiB;
constexpr size_t WS_END = WS_W + 4 * WL_BYTES;
static_assert((size_t)NUP * DM * 2 == W1_BYTES && 2 * W2_BYTES == 43 * MiB && (size_t)INW * DM * 2 == 50 * MiB, "weight map");
static_assert(WS_HFF + (size_t)M * DFF * 2 <= WS_Z && WS_Z + (size_t)M * INW * 2 <= WS_LOGF, "ws map");
constexpr int CW_BAR = 4096;

constexpr int RING_OFF = 0, RING_BYTES = 131072;
constexpr int LDSCTL_OFF = RING_BYTES, MISC_OFF = LDSCTL_OFF + 320;
constexpr int LDS_BYTES = 147456;
static_assert(MISC_OFF + 128 <= LDS_BYTES, "LDS map");

__device__ __forceinline__ float wave_sum(float v) {
#pragma unroll
    for (int o = 1; o < 64; o <<= 1) v += __shfl_xor(v, o);
    return v;
}
using pg8::bflo; using pg8::bfhi;
typedef float f32x2 __attribute__((ext_vector_type(2)));
typedef unsigned u32x2 __attribute__((ext_vector_type(2)));

__device__ __forceinline__ void tr_item(const float* __restrict__ W, int K, int N, bf16* __restrict__ WT, const float* __restrict__ gain, bool ilv, LAS float* scr, int item, int lane) {
    const int nblk = N >> 5, kb = item / nblk, nb = item - kb * nblk, k0 = kb << 6, n0 = nb << 5;
    const int lr = lane >> 3, c4 = (lane & 7) << 2;
#pragma unroll
    for (int i = 0; i < 8; ++i) {
        const int kk = 8 * i + lr;
        const f32x4 v = *(const GAS f32x4*)(W + (size_t)(k0 + kk) * N + n0 + c4);
        const float g = gain ? gain[k0 + kk] : 1.0f;
        LAS float* d = scr + kk * 33 + c4;
        d[0] = v.x * g; d[1] = v.y * g; d[2] = v.z * g; d[3] = v.w * g;
    }
    LDS_WAIT(); asm volatile("" ::: "memory");
    const int c = lane & 7;
#pragma unroll
    for (int j = 0; j < 4; ++j) {
        const int n = (lane >> 3) + 8 * j; const LAS float* s = scr + (8 * c) * 33 + n;
        v4u o; o.x = pk2(s[0 * 33], s[1 * 33]); o.y = pk2(s[2 * 33], s[3 * 33]); o.z = pk2(s[4 * 33], s[5 * 33]); o.w = pk2(s[6 * 33], s[7 * 33]);
        const int col = n0 + n; int drow = col;
        if (ilv) { const int up = col >= DFF ? 1 : 0; const int jj = up ? col - DFF : col; drow = ((jj >> 7) << 8) + (up << 7) + (jj & 127); }
        *(GAS v4u*)(WT + (size_t)drow * K + k0 + 8 * c) = o;
    }
    LDS_WAIT(); asm volatile("" ::: "memory");
}

struct Args { const float* in[13]; float* out; unsigned char* ws; int ph_lo, ph_hi; };

__device__ __forceinline__ void attn_oracle(const bf16* __restrict__ Z, bf16* __restrict__ ATT, int gw, int NGW, int lane) {
    asm volatile("" : "+v"(lane));
    const int ks = lane >> 4, dc = lane & 15;
    for (int task = gw; task < M * 4; task += NGW) {
        const int row = task >> 2, h = task & 3, t = row & (SEQ - 1);
        float mrun = -1e30f, lrun = 0.f; float o[8];
#pragma unroll
        for (int k = 0; k < 8; ++k) o[k] = 0.f;
        for (int g = 0; g < 3; ++g) {
            const int sh = 2 * g, mm = t >> sh, nk = (mm < 128 ? mm : 128) + 1;
            const int coff = g * 512 + h * 128 + 8 * dc;
            const v4u qw = *(const GAS v4u*)(Z + (size_t)row * INW + ZC_QA + coff);
            float q[8]; q[0] = bflo(qw.x); q[1] = bfhi(qw.x); q[2] = bflo(qw.y); q[3] = bfhi(qw.y); q[4] = bflo(qw.z); q[5] = bfhi(qw.z); q[6] = bflo(qw.w); q[7] = bfhi(qw.w);
            const int nit = (nk + 3) >> 2;
            for (int i = 0; i < nit; ++i) {
                const int j = 4 * i + ks; const bool valid = j < nk; const int jj = valid ? j : 0;
                const size_t kro = (size_t)(row - (jj << sh)) * INW + coff;
                const v4u kw = *(const GAS v4u*)(Z + kro + ZC_KA);
                const v4u vw = *(const GAS v4u*)(Z + kro + ZC_VA);
                float s = q[0] * bflo(kw.x) + q[1] * bfhi(kw.x) + q[2] * bflo(kw.y) + q[3] * bfhi(kw.y) + q[4] * bflo(kw.z) + q[5] * bfhi(kw.z) + q[6] * bflo(kw.w) + q[7] * bfhi(kw.w);
                s += __shfl_xor(s, 1); s += __shfl_xor(s, 2); s += __shfl_xor(s, 4); s += __shfl_xor(s, 8);
                s = valid ? s : -1e30f;
                const float mnew = fmaxf(mrun, s);
                const float alpha = __builtin_amdgcn_exp2f(mrun - mnew);
                const float p = valid ? __builtin_amdgcn_exp2f(s - mnew) : 0.f;
                lrun = lrun * alpha + p; mrun = mnew;
                o[0] = o[0] * alpha + p * bflo(vw.x); o[1] = o[1] * alpha + p * bfhi(vw.x); o[2] = o[2] * alpha + p * bflo(vw.y); o[3] = o[3] * alpha + p * bfhi(vw.y);
                o[4] = o[4] * alpha + p * bflo(vw.z); o[5] = o[5] * alpha + p * bfhi(vw.z); o[6] = o[6] * alpha + p * bflo(vw.w); o[7] = o[7] * alpha + p * bfhi(vw.w);
            }
        }
        float mall = fmaxf(mrun, __shfl_xor(mrun, 16)); mall = fmaxf(mall, __shfl_xor(mall, 32));
        const float sc = __builtin_amdgcn_exp2f(mrun - mall);
        lrun *= sc; lrun += __shfl_xor(lrun, 16); lrun += __shfl_xor(lrun, 32);
        const float inv = 1.0f / lrun;
#pragma unroll
        for (int k = 0; k < 8; ++k) { float v = o[k] * sc; v += __shfl_xor(v, 16); v += __shfl_xor(v, 32); o[k] = v * inv; }
        if (ks == 0) { v4u w; w.x = pk2(o[0], o[1]); w.y = pk2(o[2], o[3]); w.z = pk2(o[4], o[5]); w.w = pk2(o[6], o[7]); *(GAS v4u*)(ATT + (size_t)row * AW + h * 128 + 8 * dc) = w; }
    }
}
__device__ __forceinline__ void hgrn_oracle_scan(const bf16* __restrict__ Z, const float* __restrict__ LOGF, float* __restrict__ O32, int gw, int NGW, int lane) {
    asm volatile("" : "+v"(lane));
    for (int task = gw; task < 64 * 32; task += NGW) {
        const int bh = task >> 5, v4 = task & 31, b = bh >> 3, h = bh & 7;
        float s0[4], s1[4];
#pragma unroll
        for (int c = 0; c < 4; ++c) { s0[c] = 0.f; s1[c] = 0.f; }
        const size_t r0 = (size_t)b * SEQ;
#pragma unroll 4
        for (int t = 0; t < SEQ; ++t) {
            const size_t row = r0 + t;
            const f32x2 lf = *(const GAS f32x2*)(LOGF + row * 1024 + h * 128 + 2 * lane);
            const unsigned kw = *(const GAS unsigned*)(Z + row * INW + ZC_FH + h * 128 + 2 * lane);
            const unsigned qw = *(const GAS unsigned*)(Z + row * INW + ZC_QH + h * 128 + 2 * lane);
            const u32x2 iw = *(const GAS u32x2*)(Z + row * INW + ZC_IH + h * 128 + 4 * v4);
            const float f0 = __expf(lf.x), f1 = __expf(lf.y), k0 = bflo(kw), k1 = bfhi(kw), q0 = bflo(qw), q1 = bfhi(qw);
            float iv[4]; iv[0] = bflo(iw.x); iv[1] = bfhi(iw.x); iv[2] = bflo(iw.y); iv[3] = bfhi(iw.y);
            float part[4];
#pragma unroll
            for (int c = 0; c < 4; ++c) { s0[c] = f0 * s0[c] + k0 * iv[c]; s1[c] = f1 * s1[c] + k1 * iv[c]; part[c] = wave_sum(q0 * s0[c] + q1 * s1[c]); }
            if (lane == 0) *(GAS f32x4*)(O32 + row * 1024 + h * 128 + 4 * v4) = (f32x4){part[0], part[1], part[2], part[3]};
        }
    }
}
__device__ __forceinline__ void hgrn_oracle_out(const bf16* __restrict__ Z, const float* __restrict__ O32, const float* __restrict__ hnorm, bf16* __restrict__ HG, int gw, int NGW, int lane) {
    asm volatile("" : "+v"(lane));
    const float g0 = hnorm[2 * lane], g1 = hnorm[2 * lane + 1];
    for (int task = gw; task < M * 8; task += NGW) {
        const int row = task >> 3, h = task & 7;
        const f32x2 o = *(const GAS f32x2*)(O32 + (size_t)row * 1024 + h * 128 + 2 * lane);
        const float ss = wave_sum(o.x * o.x + o.y * o.y);
        const float r = __builtin_amdgcn_rsqf(ss * (1.0f / 128.0f) + RMS_EPS);
        const unsigned gwd = *(const GAS unsigned*)(Z + (size_t)row * INW + ZC_GH + h * 128 + 2 * lane);
        *(GAS unsigned*)(HG + (size_t)row * HW + h * 128 + 2 * lane) = pk2(o.x * r * g0 * bflo(gwd), o.y * r * g1 * bfhi(gwd));
    }
}

__global__ void __launch_bounds__(NWAVES * 64, 2) mk_fwd(Args args) {
    extern __shared__ __attribute__((aligned(16))) unsigned char lds_raw[];
    LAS unsigned char* lds = (LAS unsigned char*)lds_raw;
    volatile LAS unsigned* MISC = (volatile LAS unsigned*)(lds + MISC_OFF);
    const int tid = threadIdx.x, lane = tid & 63, wave = __builtin_amdgcn_readfirstlane(tid >> 6);
    const int G = gridDim.x; const int bx = blockIdx.x;
    const int vcu = (G % 8 == 0) ? (bx % 8) * (G / 8) + bx / 8 : bx;
    const int gw = vcu * NWAVES + wave, NGW = G * NWAVES;
    unsigned char* ws = args.ws;
    gu32* ctl = (gu32*)(ws + WS_CTL);
    for (int u = tid; u < (LDS_BYTES - LDSCTL_OFF) / 4; u += NWAVES * 64) ((LAS unsigned*)(lds + LDSCTL_OFF))[u] = 0u;
    __syncthreads();
    const int lo = args.ph_lo, hi = args.ph_hi;
    XcdBarrier bar; bar.bar = (unsigned*)ctl + CW_BAR; bar.x = 0; bar.st = nullptr;
    if (hi - lo > 1) bar = xcd_barrier_post((unsigned*)ctl + CW_BAR, MISC + 8);
#define IN(k) (lo <= (k) && (k) < hi)
#define SEAM() do { if (IN(ph) && IN(ph + 1)) xcd_barrier(bar); ++ph; } while (0)

    const float* x_in = args.in[0]; const float* ffn_norm = args.in[1]; const float* ffn_w_in = args.in[2]; const float* ffn_w_out = args.in[3];
    const float* mix_norm = args.in[4]; const float* w_in = args.in[5]; const float* b_gate = args.in[6]; const float* hgrn_lb = args.in[7]; const float* hgrn_norm = args.in[8];
    const float* w_pa = args.in[9]; const float* w_pm = args.in[10]; const float* w_o = args.in[11]; const float* final_norm = args.in[12];
    pg8::ss_t* ROWSS = (pg8::ss_t*)(ws + WS_ROWSS); float* LB = (float*)(ws + WS_LB);
    float* X = (float*)(ws + WS_X); bf16* XB = (bf16*)(ws + WS_XB); bf16* HFF = (bf16*)(ws + WS_HFF); bf16* Z = (bf16*)(ws + WS_Z); float* LOGF = (float*)(ws + WS_LOGF);
    bf16* ATT = (bf16*)(ws + WS_ATT); bf16* HG = (bf16*)(ws + WS_HG); float* Y32 = (float*)(ws + WS_Y32); bf16* YB = (bf16*)(ws + WS_YB); float* O32 = (float*)(ws + WS_O32);
    int ph = 0;

    if (IN(ph)) {
        LAS float* scr = (LAS float*)(lds + RING_OFF + wave * 16384);
        constexpr int I_W1 = (DM / 64) * (NUP / 32), I_W2 = (DFF / 64) * (DM / 32), I_WIN = (DM / 64) * (INW / 32), I_WPA = (AW / 64) * (DM / 32), I_WPM = (HW / 64) * (DM / 32), I_WO = (DM / 64) * (DM / 32);
        constexpr int I_LAYER = 2 * I_W1 + 2 * I_W2 + I_WIN + I_WPA + I_WPM + I_WO;
        for (int it = gw; it < DEPTH * I_LAYER; it += NGW) {
            const int l = it / I_LAYER; int r = it - l * I_LAYER;
            unsigned char* wl = ws + WS_W + (size_t)l * WL_BYTES;
            if (r < 2 * I_W1) { const int s = r >= I_W1 ? 1 : 0; r -= s * I_W1;
                tr_item(ffn_w_in + (size_t)(l * 2 + s) * DM * NUP, DM, NUP, (bf16*)(wl + WO_W1 + s * W1_BYTES), ffn_norm + (size_t)(l * 2 + s) * DM, true, scr, r, lane); continue; }
            r -= 2 * I_W1;
            if (r < 2 * I_W2) { const int s = r >= I_W2 ? 1 : 0; r -= s * I_W2;
                tr_item(ffn_w_out + (size_t)(l * 2 + s) * DFF * DM, DFF, DM, (bf16*)(wl + WO_W2 + s * W2_BYTES), nullptr, false, scr, r, lane); continue; }
            r -= 2 * I_W2;
            if (r < I_WIN) { tr_item(w_in + (size_t)l * DM * INW, DM, INW, (bf16*)(wl + WO_WIN), mix_norm + (size_t)l * DM, false, scr, r, lane); continue; }
            r -= I_WIN;
            if (r < I_WPA) { tr_item(w_pa + (size_t)l * AW * DM, AW, DM, (bf16*)(wl + WO_WPA), nullptr, false, scr, r, lane); continue; }
            r -= I_WPA;
            if (r < I_WPM) { tr_item(w_pm + (size_t)l * HW * DM, HW, DM, (bf16*)(wl + WO_WPM), nullptr, false, scr, r, lane); continue; }
            r -= I_WPM;
            tr_item(w_o + (size_t)l * DM * DM, DM, DM, (bf16*)(wl + WO_WO), nullptr, false, scr, r, lane);
        }
        for (int row = gw; row < M; row += NGW) {
            const GAS f32x4* xr = (const GAS f32x4*)(x_in + (size_t)row * DM) + lane;
            GAS f32x4* xo = (GAS f32x4*)(X + (size_t)row * DM) + lane;
            GAS unsigned long long* xb8 = (GAS unsigned long long*)(XB + (size_t)row * DM) + lane;
            f32x4 v[8]; float s = 0.f;
#pragma unroll
            for (int j = 0; j < 8; ++j) { v[j] = xr[64 * j]; s += (v[j].x * v[j].x + v[j].y * v[j].y) + (v[j].z * v[j].z + v[j].w * v[j].w); }
            s = wave_sum(s);
#pragma unroll
            for (int j = 0; j < 8; ++j) { xo[64 * j] = v[j]; xb8[64 * j] = (unsigned long long)pk2(v[j].x, v[j].y) | ((unsigned long long)pk2(v[j].z, v[j].w) << 32); }
            if (lane == 0) ROWSS[row] = pg8::ss_fix(s);
        }
        for (int c = gw * 64 + lane; c < 1024; c += NGW * 64) {
            const float a0 = hgrn_lb[c], a1 = hgrn_lb[1024 + c], a2 = hgrn_lb[2048 + c], a3 = hgrn_lb[3072 + c];
            const float mx = fmaxf(fmaxf(a0, a1), fmaxf(a2, a3));
            const float e0 = __expf(a0 - mx), e1 = __expf(a1 - mx), e2 = __expf(a2 - mx), e3 = __expf(a3 - mx);
            const float inv = 1.0f / (e0 + e1 + e2 + e3);
            LB[c] = 0.f; LB[1024 + c] = e1 * inv; LB[2048 + c] = (e1 + e2) * inv; LB[3072 + c] = (e1 + e2 + e3) * inv;
        }
    }
    SEAM();

    for (int i = 0; i < 8; ++i) {
        const int l = i >> 1, s = i & 1;
        unsigned char* wl = ws + WS_W + (size_t)l * WL_BYTES;
        {
            const pg8::ss_t* rs_in = ROWSS + (size_t)(3 * l + 2 * s) * M; pg8::ss_t* rs_out = ROWSS + (size_t)(3 * l + 2 * s + 1) * M;
            if (IN(ph)) {
                pg8::Gemm g{XB, (const bf16*)(wl + WO_W1 + s * W1_BYTES), M, NUP, DM}; pg8::StaticOrder S; S.init(M, NUP, G, bx);
                pg8::EpiFfnUp E{HFF, rs_in};
                pg8::gemm_phase<pg8::EpiFfnUp, pg8::StaticOrder, true, true>(lds + RING_OFF, g, S, E);
            }
            SEAM();
            if (IN(ph)) {
                pg8::Gemm g{HFF, (const bf16*)(wl + WO_W2 + s * W2_BYTES), M, DM, DFF}; pg8::StaticOrder S; S.init(M, DM, G, bx);
                pg8::EpiResid E{X, XB, rs_out, 0.5f};
                pg8::gemm_phase<pg8::EpiResid, pg8::StaticOrder, true, true>(lds + RING_OFF, g, S, E);
            }
            SEAM();
        }
        if (s == 0) {
            const pg8::ss_t* rs_in = ROWSS + (size_t)(3 * l + 1) * M; pg8::ss_t* rs_out = ROWSS + (size_t)(3 * l + 2) * M;
            if (IN(ph)) {
                pg8::Gemm g{XB, (const bf16*)(wl + WO_WIN), M, INW, DM}; pg8::StaticOrder S; S.init(M, INW, G, bx);
                pg8::EpiZ E{Z, LOGF, rs_in, LB + l * 1024, b_gate + (size_t)l * 2 * DM};
                pg8::gemm_phase<pg8::EpiZ, pg8::StaticOrder, true, true>(lds + RING_OFF, g, S, E);
            }
            SEAM();
            if (IN(ph)) {
                hgrn_oracle_scan(Z, LOGF, O32, gw, NGW, lane);
                attn_oracle(Z, ATT, gw, NGW, lane);
            }
            SEAM();
            if (IN(ph)) hgrn_oracle_out(Z, O32, hgrn_norm + l * 128, HG, gw, NGW, lane);
            SEAM();
            if (IN(ph)) {
                { pg8::Gemm g{ATT, (const bf16*)(wl + WO_WPA), M, DM, AW}; pg8::StaticOrder S; S.init(M, DM, G, bx);
                  pg8::EpiPa E{Z, Y32};
                  pg8::gemm_phase<pg8::EpiPa, pg8::StaticOrder, true, true>(lds + RING_OFF, g, S, E); }
                { pg8::Gemm g{HG, (const bf16*)(wl + WO_WPM), M, DM, HW}; pg8::StaticOrder S; S.init(M, DM, G, bx);
                  pg8::EpiPm E{Z, Y32, YB};
                  pg8::gemm_phase<pg8::EpiPm, pg8::StaticOrder, true, true>(lds + RING_OFF, g, S, E); }
            }
            SEAM();
            if (IN(ph)) {
                pg8::Gemm g{YB, (const bf16*)(wl + WO_WO), M, DM, DM}; pg8::StaticOrder S; S.init(M, DM, G, bx);
                pg8::EpiResid E{X, XB, rs_out, 1.0f};
                pg8::gemm_phase<pg8::EpiResid, pg8::StaticOrder, true, true>(lds + RING_OFF, g, S, E);
            }
            SEAM();
        }
    }
    if (IN(ph)) {
        const pg8::ss_t* rs = ROWSS + (size_t)12 * M;
        for (int row = gw; row < M; row += NGW) {
            const float r = pg8::rstd_of(rs[row]);
            const GAS f32x4* xr = (const GAS f32x4*)(X + (size_t)row * DM) + lane;
            const GAS f32x4* gn = (const GAS f32x4*)final_norm + lane;
            GAS f32x4* orow = (GAS f32x4*)(args.out + (size_t)row * DM) + lane;
#pragma unroll
            for (int j = 0; j < 8; ++j) { const f32x4 v = xr[64 * j], g = gn[64 * j]; orow[64 * j] = (f32x4){v.x * r * g.x, v.y * r * g.y, v.z * r * g.z, v.w * r * g.w}; }
        }
    }
#undef IN
#undef SEAM
}

extern "C" void kernel_launch(void* const* d_in, const int* in_sizes, int n_in, void* d_out, int out_size, void* d_ws, size_t ws_size, hipStream_t stream) {
    static int grid = 0;
    if (grid == 0) {
        if (n_in != 13 || in_sizes[0] != M * DM || out_size != M * DM || ws_size < WS_END) { fprintf(stderr, "kernel_launch: unexpected shapes (n_in %d, in0 %d, out %d, ws %zu < %zu?); nothing launched\n", n_in, n_in > 0 ? in_sizes[0] : -1, out_size, ws_size, (size_t)WS_END); grid = -1; return; }
        int dev = 0, cus = 0, per_cu = 0;
        if (hipGetDevice(&dev) != hipSuccess || hipDeviceGetAttribute(&cus, hipDeviceAttributeMultiprocessorCount, dev) != hipSuccess) { grid = -1; return; }
        if (hipFuncSetAttribute((const void*)mk_fwd, hipFuncAttributeMaxDynamicSharedMemorySize, LDS_BYTES) != hipSuccess) { fprintf(stderr, "kernel_launch: hipFuncSetAttribute failed\n"); grid = -1; return; }
        if (hipOccupancyMaxActiveBlocksPerMultiprocessor(&per_cu, (const void*)mk_fwd, NWAVES * 64, LDS_BYTES) != hipSuccess || per_cu < 1) { fprintf(stderr, "kernel_launch: occupancy query says %d blocks per CU\n", per_cu); }
        (void)hipGetLastError();
        grid = cus;
    }
    if (grid < 0) return;
    if (hipMemsetAsync((char*)d_ws + WS_CTL, 0, CTL_ZERO_BYTES, stream) != hipSuccess) { fprintf(stderr, "kernel_launch: memset failed\n"); return; }
    Args a{};
    for (int i = 0; i < 13; ++i) a.in[i] = (const float*)d_in[i];
    a.out = (float*)d_out; a.ws = (unsigned char*)d_ws;
#if MK_ONE_LAUNCH
    a.ph_lo = 0; a.ph_hi = N_PHASES;
    hipLaunchKernelGGL(mk_fwd, dim3(grid), dim3(NWAVES * 64), LDS_BYTES, stream, a);
#else
    for (int p = 0; p < N_PHASES; ++p) { a.ph_lo = p; a.ph_hi = p + 1; hipLaunchKernelGGL(mk_fwd, dim3(grid), dim3(NWAVES * 64), LDS_BYTES, stream, a); }
#endif
    const hipError_t le = hipPeekAtLastError();
    if (le != hipSuccess) fprintf(stderr, "kernel_launch: launch failed: %s\n", hipGetErrorName(le));
}
```

```cpp
#include <hip/hip_runtime.h>
#include <cstdio>
#include <cstdint>
namespace pg8 {
#define PG8_LAS __attribute__((address_space(3)))
typedef unsigned short bf16_t;
typedef short bf16x8 __attribute__((ext_vector_type(8)));
typedef float f32x4 __attribute__((ext_vector_type(4)));
typedef unsigned u32x4 __attribute__((ext_vector_type(4)));
constexpr int BM = 256, BK = 64, HALF = 128, HTB = HALF * BK * 2  , STAGE_BYTES = 8 * HTB, NXCD = 8, WGM = 8;

__host__ __device__ __forceinline__ int lds_byte(int r, int c) { const int st = (r >> 4) * 2 + (c >> 5), rr = r & 15, cc = c & 31, ob = rr * 64 + cc * 2; return st * 1024 + (ob ^ (((ob >> 9) & 1) << 5)); }
__host__ __device__ __forceinline__ void stage_rc(int b, int& R, int& C) { const int st = b / 1024, sb = b % 1024, swz = sb ^ (((sb >> 9) & 1) << 5); R = (st >> 1) * 16 + swz / 64; C = (st & 1) * 32 + (swz % 64) / 2; }
__host__ __device__ __forceinline__ int perm32(int rho) { const int n = rho >> 4, i = rho & 15; return 8 * (i >> 2) + 4 * n + (i & 3); }

struct Unit { int pm, pn; };
struct Gemm { const bf16_t* A; const bf16_t* Bt; int M, N, K; };

struct StaticOrder {
    int nM, nN, nwg, G, c;
    __host__ __device__ void init(int M, int N, int G_, int c_) { nM = M / BM; nN = N / BM; nwg = nM * nN; G = G_; c = c_; }
    __host__ __device__ bool next(int i, Unit& u) const {
        const long L = (long)i * G + c; if (L >= nwg) return false;
        int wgid = (int)L; { const int q = nwg / NXCD, r = nwg % NXCD, xcd = wgid % NXCD, off = wgid / NXCD; wgid = (xcd < r ? xcd * (q + 1) : r * (q + 1) + (xcd - r) * q) + off; }
        const int nig = WGM * nN, gid = wgid / nig, fm = gid * WGM, gsz = (nM - fm) < WGM ? (nM - fm) : WGM;
        u.pm = fm + ((wgid % nig) % gsz); u.pn = (wgid % nig) / gsz; return true;
    }
    __device__ __forceinline__ void a_ready(const Unit&) const {}
    __device__ __forceinline__ void done(const Unit&) const {}
};
typedef __bf16 bf16x2_t __attribute__((ext_vector_type(2)));
typedef float f32x2_t __attribute__((ext_vector_type(2)));
__device__ __forceinline__ unsigned cvt_pk_bf16(float lo, float hi) { const f32x2_t v = {lo, hi}; const bf16x2_t b = __builtin_convertvector(v, bf16x2_t); return __builtin_bit_cast(unsigned, b); }
constexpr float RMS_EPS = 1e-6f;
constexpr int DM = 2048, DFF = 5504, INW = 12800;
typedef unsigned long long ss_t;
__device__ __forceinline__ ss_t ss_fix(float ss) { return (ss_t)(ss * 4294967296.0f); }
__device__ __forceinline__ float rstd_of(ss_t ss) { return __builtin_amdgcn_rsqf((float)ss * (1.0f / 4294967296.0f / 2048.0f) + RMS_EPS); }
__device__ __forceinline__ float sigmoid_f(float x) { return __builtin_amdgcn_rcpf(1.0f + __expf(-x)); }
__device__ __forceinline__ float silu_f(float x) { return x * sigmoid_f(x); }
typedef unsigned u32x2 __attribute__((ext_vector_type(2)));
__device__ __forceinline__ int lane_id_fresh() { int l; asm volatile("v_mbcnt_lo_u32_b32 %0, -1, 0\n\tv_mbcnt_hi_u32_b32 %0, -1, %0" : "=v"(l)); return l; }
__device__ __forceinline__ float ub0(unsigned w) { return (float)(w & 0xffu); }
__device__ __forceinline__ float ub1(unsigned w) { return (float)((w >> 8) & 0xffu); }
__device__ __forceinline__ float ub2(unsigned w) { return (float)((w >> 16) & 0xffu); }
__device__ __forceinline__ float ub3(unsigned w) { return (float)(w >> 24); }
__device__ __forceinline__ float bflo(unsigned w) { return __uint_as_float(w << 16); }
__device__ __forceinline__ float bfhi(unsigned w) { return __uint_as_float(w & 0xffff0000u); }

struct EpiFfnUp {
    static constexpr bool PERM = true, AFTER_DRAIN = false;
    struct State { ss_t rs[8]; };
    bf16_t* H; const ss_t* rowss;
    __device__ __forceinline__ void init(f32x4 (&acc)[2][2][4][2], State& st, const Unit& u, int wr, int wc, int fr, int fq) const {
#pragma unroll
        for (int ai = 0; ai < 2; ++ai)
#pragma unroll
            for (int m = 0; m < 4; ++m) st.rs[ai * 4 + m] = rowss[u.pm * BM + wr * 64 + fr + ai * HALF + m * 16];
#pragma unroll
        for (int a = 0; a < 2; ++a)
#pragma unroll
            for (int b = 0; b < 2; ++b)
#pragma unroll
                for (int m = 0; m < 4; ++m)
#pragma unroll
                    for (int n = 0; n < 2; ++n) acc[a][b][m][n] = (f32x4){0.f, 0.f, 0.f, 0.f};
    }
    __device__ __forceinline__ void operator()(const f32x4 (&acc)[2][2][4][2], const State& st, const Unit& u, int wr, int wc, int fr, int fq) const {
        const int row0 = u.pm * BM + wr * 64 + fr, col0 = u.pn * 128 + wc * 32 + 8 * fq;
#pragma unroll
        for (int ai = 0; ai < 2; ++ai)
#pragma unroll
            for (int m = 0; m < 4; ++m) {
                const int row = row0 + ai * HALF + m * 16; const float rs = rstd_of(st.rs[ai * 4 + m]);
                float h[8];
#pragma unroll
                for (int n = 0; n < 2; ++n)
#pragma unroll
                    for (int j = 0; j < 4; ++j) { const float g = rs * acc[ai][0][m][n][j], up = rs * acc[ai][1][m][n][j]; h[4 * n + j] = silu_f(g) * up; }
                u32x4 w; w.x = cvt_pk_bf16(h[0], h[1]); w.y = cvt_pk_bf16(h[2], h[3]); w.z = cvt_pk_bf16(h[4], h[5]); w.w = cvt_pk_bf16(h[6], h[7]);
                *(u32x4*)(H + (size_t)row * DFF + col0) = w;
            }
    }
};
struct EpiResid {
    static constexpr bool PERM = true, AFTER_DRAIN = false;
    struct State {};
    bf16_t* XB; ss_t* rowss_out; float scale, inv_scale;
    __device__ __forceinline__ void init(f32x4 (&acc)[2][2][4][2], State&, const Unit& u, int wr, int wc, int fr, int fq) const {
        const int row0 = u.pm * BM + wr * 64 + fr, col0 = u.pn * BM + wc * 32 + 8 * fq;
#pragma unroll
        for (int ai = 0; ai < 2; ++ai)
#pragma unroll
            for (int m = 0; m < 4; ++m)
#pragma unroll
                for (int bj = 0; bj < 2; ++bj) {
                    const u32x4 xw = *(const u32x4*)(XB + (size_t)(row0 + ai * HALF + m * 16) * DM + col0 + bj * HALF);
                    acc[ai][bj][m][0] = (f32x4){bflo(xw.x), bfhi(xw.x), bflo(xw.y), bfhi(xw.y)} * inv_scale; acc[ai][bj][m][1] = (f32x4){bflo(xw.z), bfhi(xw.z), bflo(xw.w), bfhi(xw.w)} * inv_scale;
                }
    }
    __device__ __forceinline__ void operator()(const f32x4 (&acc)[2][2][4][2], const State& st, const Unit& u, int wr, int wc, int fr, int fq) const {
        const int row0 = u.pm * BM + wr * 64 + fr, col0 = u.pn * BM + wc * 32 + 8 * fq;
#pragma unroll
        for (int ai = 0; ai < 2; ++ai)
#pragma unroll
            for (int m = 0; m < 4; ++m) {
                const int row = row0 + ai * HALF + m * 16; float ss = 0.f;
#pragma unroll
                for (int bj = 0; bj < 2; ++bj) {
                    const f32x4 x0 = acc[ai][bj][m][0] * scale, x1 = acc[ai][bj][m][1] * scale;
                    u32x4 w; w.x = cvt_pk_bf16(x0[0], x0[1]); w.y = cvt_pk_bf16(x0[2], x0[3]); w.z = cvt_pk_bf16(x1[0], x1[1]); w.w = cvt_pk_bf16(x1[2], x1[3]);
                    *(u32x4*)(XB + (size_t)row * DM + col0 + bj * HALF) = w;
                    ss += (x0[0] * x0[0] + x0[1] * x0[1]) + (x0[2] * x0[2] + x0[3] * x0[3]) + (x1[0] * x1[0] + x1[1] * x1[1]) + (x1[2] * x1[2] + x1[3] * x1[3]);
                }
                ss += __shfl_xor(ss, 16); ss += __shfl_xor(ss, 32);
                if (fq == 0) __hip_atomic_fetch_add(rowss_out + row, ss_fix(ss), __ATOMIC_RELAXED, __HIP_MEMORY_SCOPE_AGENT);
            }
    }
};
constexpr float QSCALE = 0.08838834764831845f * 1.4426950408889634f;
constexpr int ZC_QA = 0, ZC_KA = 1536, ZC_VA = 3072, ZC_QH = 4608, ZC_FH = 5632, ZC_IH = 6656, ZC_GH = 7680, ZC_GA = 8704, ZC_GM = 10752;
constexpr int M_ROWS = 16384, SEQ_LEN = 2048;
constexpr size_t QKV_PART = (size_t)M_ROWS * 1536, HB_PART = (size_t)M_ROWS * 1024;
struct EpiZ {
    static constexpr bool PERM = true, AFTER_DRAIN = false;
    struct State { ss_t rs[8]; };
    bf16_t* QKV; bf16_t* HB; unsigned char* GATES; float* LOGF; const ss_t* rowss; const float* lb; const float* bgate;
    __device__ __forceinline__ void init(f32x4 (&acc)[2][2][4][2], State& st, const Unit& u, int wr, int wc, int fr, int fq) const {
#pragma unroll
        for (int ai = 0; ai < 2; ++ai)
#pragma unroll
            for (int m = 0; m < 4; ++m) st.rs[ai * 4 + m] = rowss[u.pm * BM + wr * 64 + fr + ai * HALF + m * 16];
#pragma unroll
        for (int a = 0; a < 2; ++a)
#pragma unroll
            for (int b = 0; b < 2; ++b)
#pragma unroll
                for (int m = 0; m < 4; ++m)
#pragma unroll
                    for (int n = 0; n < 2; ++n) acc[a][b][m][n] = (f32x4){0.f, 0.f, 0.f, 0.f};
    }
    __device__ __forceinline__ void operator()(const f32x4 (&acc)[2][2][4][2], const State& st, const Unit& u, int wr, int wc, int fr, int fq) const {
        const int pn = u.pn;
        const int mode = pn < 6 ? 0 : pn < 18 ? 1 : pn < 22 ? 2 : pn < 26 ? 3 : pn < 30 ? 1 : pn < 34 ? 2 : 4;
        const int region = pn < 18 ? 0 : pn < 34 ? 1 : 2;
        const int row0 = u.pm * BM + wr * 64 + fr, colb = pn * BM + wc * 32 + 8 * fq;
#pragma unroll
        for (int bj = 0; bj < 2; ++bj) {
            float par[8];
            {
                f32x4 p0 = (f32x4){0.f, 0.f, 0.f, 0.f}, p1 = p0;
                if (mode == 3) { const float* p = lb + (colb + bj * HALF - ZC_FH); p0 = *(const f32x4*)p; p1 = *(const f32x4*)(p + 4); }
                if (mode == 4) { const float* p = bgate + (colb + bj * HALF - ZC_GA); p0 = *(const f32x4*)p; p1 = *(const f32x4*)(p + 4); }
#pragma unroll
                for (int j = 0; j < 4; ++j) { par[j] = p0[j]; par[4 + j] = p1[j]; }
            }
            const int c0 = colb + bj * HALF;
#pragma unroll
            for (int ai = 0; ai < 2; ++ai)
#pragma unroll
                for (int m = 0; m < 4; ++m) {
                    const int row = row0 + ai * HALF + m * 16; const float rs = rstd_of(st.rs[ai * 4 + m]);
                    const int b = row >> 11, t = row & (SEQ_LEN - 1);
                    float v[8];
#pragma unroll
                    for (int n = 0; n < 2; ++n)
#pragma unroll
                        for (int j = 0; j < 4; ++j) v[4 * n + j] = rs * acc[ai][bj][m][n][j];
                    bf16_t* dst;
                    if (region == 0) {
                        const int part = c0 / 1536, cip = c0 - part * 1536, g = cip >> 9, hh = (cip >> 7) & 3, d = cip & 127, sh = 2 * g;
                        const int pt = ((t & ((1 << sh) - 1)) << (11 - sh)) + (t >> sh);
                        dst = QKV + (size_t)part * QKV_PART + ((size_t)(((b * 3 + g) * 4 + hh) * SEQ_LEN + pt) * 128 + d);
                    } else if (region == 1) {
                        const int hp = (c0 - ZC_QH) >> 10, cip = (c0 - ZC_QH) & 1023, hh = cip >> 7, k = cip & 127;
                        const size_t off = (size_t)((b * 8 + hh) * SEQ_LEN + t) * 128 + k;
                        dst = HB + (size_t)hp * HB_PART + off;
                        if (mode == 3) {
                            float lg[8];
#pragma unroll
                            for (int j = 0; j < 8; ++j) { const float l = par[j], fl = v[j]; const float sg = sigmoid_f(fl); lg[j] = __builtin_amdgcn_logf(l + (1.0f - l) * sg); v[j] = (1.0f - l) * __builtin_amdgcn_rcpf(1.0f + __expf(fl)); }
                            float* lp = LOGF + off;
                            *(f32x4*)lp = (f32x4){lg[0], lg[1], lg[2], lg[3]}; *(f32x4*)(lp + 4) = (f32x4){lg[4], lg[5], lg[6], lg[7]};
                        }
                    } else {
                        unsigned q[8];
#pragma unroll
                        for (int j = 0; j < 8; ++j) q[j] = (unsigned)(sigmoid_f(v[j] + par[j]) * 255.0f + 0.5f);
                        u32x2 gw8; gw8.x = q[0] | (q[1] << 8) | (q[2] << 16) | (q[3] << 24); gw8.y = q[4] | (q[5] << 8) | (q[6] << 16) | (q[7] << 24);
                        *(u32x2*)(GATES + (size_t)row * 4096 + (c0 - ZC_GA)) = gw8;
                        continue;
                    }
                    if (mode == 0) {
#pragma unroll
                        for (int j = 0; j < 8; ++j) v[j] *= QSCALE;
                    } else if (mode == 2) {
#pragma unroll
                        for (int j = 0; j < 8; ++j) v[j] = silu_f(v[j]);
                    }
                    u32x4 w; w.x = cvt_pk_bf16(v[0], v[1]); w.y = cvt_pk_bf16(v[2], v[3]); w.z = cvt_pk_bf16(v[4], v[5]); w.w = cvt_pk_bf16(v[6], v[7]);
                    *(u32x4*)dst = w;
                }
        }
    }
};
struct EpiPa {
    static constexpr bool PERM = true, AFTER_DRAIN = false;
    struct State {};
    const unsigned char* GATES; bf16_t* YA;
    __device__ __forceinline__ void init(f32x4 (&acc)[2][2][4][2], State&, const Unit&, int, int, int, int) const {
#pragma unroll
        for (int a = 0; a < 2; ++a)
#pragma unroll
            for (int b = 0; b < 2; ++b)
#pragma unroll
                for (int m = 0; m < 4; ++m)
#pragma unroll
                    for (int n = 0; n < 2; ++n) acc[a][b][m][n] = (f32x4){0.f, 0.f, 0.f, 0.f};
    }
    __device__ __forceinline__ void operator()(const f32x4 (&acc)[2][2][4][2], const State& st, const Unit& u, int wr, int wc, int fr, int fq) const {
        const int row0 = u.pm * BM + wr * 64 + fr, col0 = u.pn * BM + wc * 32 + 8 * fq;
        u32x2 g[2][4][2];
#pragma unroll
        for (int ai = 0; ai < 2; ++ai)
#pragma unroll
            for (int m = 0; m < 4; ++m)
#pragma unroll
                for (int bj = 0; bj < 2; ++bj) g[ai][m][bj] = *(const u32x2*)(GATES + (size_t)(row0 + ai * HALF + m * 16) * 4096 + col0 + bj * HALF);
#pragma unroll
        for (int ai = 0; ai < 2; ++ai)
#pragma unroll
            for (int m = 0; m < 4; ++m)
#pragma unroll
                for (int bj = 0; bj < 2; ++bj) {
                    const u32x2 gg = g[ai][m][bj]; const f32x4 a0 = acc[ai][bj][m][0] * (1.0f / 255.0f), a1 = acc[ai][bj][m][1] * (1.0f / 255.0f);
                    u32x4 w; w.x = cvt_pk_bf16(ub0(gg.x) * a0[0], ub1(gg.x) * a0[1]); w.y = cvt_pk_bf16(ub2(gg.x) * a0[2], ub3(gg.x) * a0[3]);
                    w.z = cvt_pk_bf16(ub0(gg.y) * a1[0], ub1(gg.y) * a1[1]); w.w = cvt_pk_bf16(ub2(gg.y) * a1[2], ub3(gg.y) * a1[3]);
                    *(u32x4*)(YA + (size_t)(row0 + ai * HALF + m * 16) * DM + col0 + bj * HALF) = w;
                }
    }
};
struct EpiPm {
    static constexpr bool PERM = true, AFTER_DRAIN = false;
    struct State {};
    const unsigned char* GATES; const bf16_t* YA; bf16_t* YB;
    __device__ __forceinline__ void init(f32x4 (&acc)[2][2][4][2], State&, const Unit&, int, int, int, int) const {
#pragma unroll
        for (int a = 0; a < 2; ++a)
#pragma unroll
            for (int b = 0; b < 2; ++b)
#pragma unroll
                for (int m = 0; m < 4; ++m)
#pragma unroll
                    for (int n = 0; n < 2; ++n) acc[a][b][m][n] = (f32x4){0.f, 0.f, 0.f, 0.f};
    }
    __device__ __forceinline__ void operator()(const f32x4 (&acc)[2][2][4][2], const State& st, const Unit& u, int wr, int wc, int fr, int fq) const {
        const int row0 = u.pm * BM + wr * 64 + fr, col0 = u.pn * BM + wc * 32 + 8 * fq;
#pragma unroll
        for (int ai = 0; ai < 2; ++ai) {
            u32x2 g[4][2]; u32x4 y[4][2];
#pragma unroll
            for (int m = 0; m < 4; ++m)
#pragma unroll
                for (int bj = 0; bj < 2; ++bj) {
                    g[m][bj] = *(const u32x2*)(GATES + (size_t)(row0 + ai * HALF + m * 16) * 4096 + 2048 + col0 + bj * HALF);
                    y[m][bj] = *(const u32x4*)(YA + (size_t)(row0 + ai * HALF + m * 16) * DM + col0 + bj * HALF);
                }
#pragma unroll
            for (int m = 0; m < 4; ++m)
#pragma unroll
                for (int bj = 0; bj < 2; ++bj) {
                    const u32x2 gg = g[m][bj]; const u32x4 yy = y[m][bj]; const f32x4 a0 = acc[ai][bj][m][0] * (1.0f / 255.0f), a1 = acc[ai][bj][m][1] * (1.0f / 255.0f);
                    u32x4 w;
                    w.x = cvt_pk_bf16(bflo(yy.x) + ub0(gg.x) * a0[0], bfhi(yy.x) + ub1(gg.x) * a0[1]); w.y = cvt_pk_bf16(bflo(yy.y) + ub2(gg.x) * a0[2], bfhi(yy.y) + ub3(gg.x) * a0[3]);
                    w.z = cvt_pk_bf16(bflo(yy.z) + ub0(gg.y) * a1[0], bfhi(yy.z) + ub1(gg.y) * a1[1]); w.w = cvt_pk_bf16(bflo(yy.w) + ub2(gg.y) * a1[2], bfhi(yy.w) + ub3(gg.y) * a1[3]);
                    *(u32x4*)(YB + (size_t)(row0 + ai * HALF + m * 16) * DM + col0 + bj * HALF) = w;
                }
        }
    }
};
template <class Epi, class Sched, bool ALIGN_EPI = false, bool SP2 = false>
__device__ __forceinline__ void gemm_phase(PG8_LAS unsigned char* lds, const Gemm g, const Sched& S, const Epi& E, int wave_id) {
    int wid_l = wave_id; asm volatile("" : "+s"(wid_l));
    const int lane = lane_id_fresh(), wid = wid_l, tid = wid * 64 + lane, wr = wid >> 2, wc = wid & 3, fr = lane & 15, fq = lane >> 4;
    const int K = g.K, nt = K / BK;
    unsigned voffA[2], voffB[2];
#pragma unroll
    for (int i = 0; i < 2; ++i) { int R, C; stage_rc(tid * 16 + i * 8192, R, C); const int Rb = Epi::PERM ? ((R & ~31) + perm32(R & 31)) : R;
        voffA[i] = (unsigned)(R * K + C) * 2u; voffB[i] = (unsigned)(Rb * K + C) * 2u; }
    const size_t kstep = (size_t)(BK * 2);
    const size_t hstep = (size_t)HALF * K * 2;
    const size_t tstep = 2 * hstep;
    const unsigned ldsw = (unsigned)wid * 1024u;
    const int aoff = lds_byte(wr * 64 + fr, fq * 8), boff = lds_byte(wc * 32 + fr, fq * 8);
#define PG8_SA(b, h) (((b) * 2 + (h)) * HTB)
#define PG8_SB(b, h) ((4 + (b) * 2 + (h)) * HTB)
#define PG8_STAGE(bufoff, gbase, voff) do { _Pragma("unroll") for (int _i = 0; _i < 2; ++_i) \
        __builtin_amdgcn_global_load_lds((const unsigned*)((const char*)(gbase) + (voff)[_i]), (PG8_LAS unsigned*)(lds + (bufoff) + ldsw + _i * 8192), 16, 0, 0); } while (0)
#define PG8_LDA(dst, b, h) do { _Pragma("unroll") for (int m = 0; m < 4; ++m) _Pragma("unroll") for (int k = 0; k < 2; ++k) dst[m][k] = *(const PG8_LAS bf16x8*)(lds + PG8_SA(b, h) + aoff + m * 2048 + k * 1024); } while (0)
#define PG8_LDB(dst, b, h) do { _Pragma("unroll") for (int n = 0; n < 2; ++n) _Pragma("unroll") for (int k = 0; k < 2; ++k) dst[n][k] = *(const PG8_LAS bf16x8*)(lds + PG8_SB(b, h) + boff + n * 2048 + k * 1024); } while (0)
#define PG8_MMA(ai, bj, At, Bt) do { __builtin_amdgcn_s_setprio(1); _Pragma("unroll") for (int m = 0; m < 4; ++m) _Pragma("unroll") for (int n = 0; n < 2; ++n) _Pragma("unroll") for (int k = 0; k < 2; ++k) \
        acc[ai][bj][m][n] = __builtin_amdgcn_mfma_f32_16x16x32_bf16(Bt[n][k], At[m][k], acc[ai][bj][m][n], 0, 0, 0); __builtin_amdgcn_s_setprio(0); } while (0)
#define PG8_WAIT_V(n) asm volatile("s_waitcnt vmcnt(" #n ")" ::: "memory")
#define PG8_WAIT_L(n) asm volatile("s_waitcnt lgkmcnt(" #n ")" ::: "memory")
#define PG8_BAR __builtin_amdgcn_s_barrier()
#define PG8_SCHED __builtin_amdgcn_sched_barrier(0)
    Unit cur, nxt; int ui = 0;
    if (!S.next(0, cur)) return;
    f32x4 acc[2][2][4][2]; typename Epi::State est;
    E.init(acc, est, cur, wr, wc, fr, fq);
    bf16x8 At[4][2], B0[2][2], B1[2][2];
    const char* cA = (const char*)g.A + (size_t)cur.pm * tstep; const char* cB = (const char*)g.Bt + (size_t)cur.pn * tstep;
    S.a_ready(cur);
    if constexpr (SP2) {
        PG8_STAGE(PG8_SB(0, 0), cB, voffB); PG8_STAGE(PG8_SB(0, 1), cB + hstep, voffB); PG8_STAGE(PG8_SA(0, 0), cA, voffA); PG8_STAGE(PG8_SA(0, 1), cA + hstep, voffA);
        if (wr == 1) PG8_BAR;
        PG8_WAIT_V(2); PG8_BAR;
        PG8_STAGE(PG8_SB(1, 0), cB + kstep, voffB); PG8_STAGE(PG8_SA(1, 0), cA + kstep, voffA); PG8_STAGE(PG8_SB(1, 1), cB + hstep + kstep, voffB);
        PG8_WAIT_V(6); PG8_BAR;
    } else {
        PG8_STAGE(PG8_SB(0, 0), cB, voffB); PG8_STAGE(PG8_SA(0, 0), cA, voffA); PG8_STAGE(PG8_SB(0, 1), cB + hstep, voffB); PG8_STAGE(PG8_SA(0, 1), cA + hstep, voffA);
        if (wr == 1) PG8_BAR;
        PG8_WAIT_V(4); PG8_BAR;
        PG8_STAGE(PG8_SB(1, 0), cB + kstep, voffB); PG8_STAGE(PG8_SA(1, 0), cA + kstep, voffA); PG8_STAGE(PG8_SB(1, 1), cB + hstep + kstep, voffB);
        PG8_WAIT_V(6); PG8_BAR;
    }
    for (;;) {
        const bool has_next = S.next(ui + 1, nxt);
        const char* nA = has_next ? (const char*)g.A + (size_t)nxt.pm * tstep : cA; const char* nB = has_next ? (const char*)g.Bt + (size_t)nxt.pn * tstep : cB;
        for (int t = 0; t < nt; t += 2) {
            const bool last = (t == nt - 2);
            const char* a1 = cA + (size_t)(t + 1) * kstep;
            const char* a2 = last ? nA : cA + (size_t)(t + 2) * kstep; const char* b2 = last ? nB : cB + (size_t)(t + 2) * kstep;
            const char* a3 = a2 + kstep; const char* b3 = b2 + kstep;
            if (last && has_next) S.a_ready(nxt);
            if constexpr (SP2) {
            PG8_LDB(B0, 0, 0); PG8_LDB(B1, 0, 1); PG8_SCHED; PG8_LDA(At, 0, 0); PG8_STAGE(PG8_SA(1, 1), a1 + hstep, voffA);
            PG8_WAIT_V(8); PG8_WAIT_L(0); PG8_BAR; PG8_MMA(0, 0, At, B0); PG8_MMA(0, 1, At, B1); PG8_BAR; PG8_SCHED;
            PG8_LDA(At, 0, 1); PG8_STAGE(PG8_SB(0, 0), b2, voffB); PG8_STAGE(PG8_SB(0, 1), b2 + hstep, voffB); PG8_STAGE(PG8_SA(0, 0), a2, voffA);
            PG8_WAIT_V(8); PG8_WAIT_L(0); PG8_BAR; PG8_MMA(1, 0, At, B0); PG8_MMA(1, 1, At, B1); PG8_BAR; PG8_SCHED;
            PG8_LDB(B0, 1, 0); PG8_LDB(B1, 1, 1); PG8_SCHED; PG8_LDA(At, 1, 0); PG8_STAGE(PG8_SA(0, 1), a2 + hstep, voffA);
            PG8_WAIT_V(8); PG8_WAIT_L(0); PG8_BAR; PG8_MMA(0, 0, At, B0); PG8_MMA(0, 1, At, B1); PG8_BAR; PG8_SCHED;
            PG8_LDA(At, 1, 1); PG8_STAGE(PG8_SB(1, 0), b3, voffB); PG8_STAGE(PG8_SB(1, 1), b3 + hstep, voffB); PG8_STAGE(PG8_SA(1, 0), a3, voffA);
            PG8_WAIT_V(8); PG8_WAIT_L(0); PG8_BAR; PG8_MMA(1, 0, At, B0); PG8_MMA(1, 1, At, B1); PG8_BAR; PG8_SCHED;
            } else {
            PG8_LDB(B0, 0, 0); PG8_SCHED; PG8_LDA(At, 0, 0); PG8_STAGE(PG8_SA(1, 1), a1 + hstep, voffA);
            PG8_WAIT_L(8); PG8_BAR; PG8_WAIT_L(0); PG8_MMA(0, 0, At, B0); PG8_BAR; PG8_SCHED;
            PG8_LDB(B1, 0, 1); PG8_STAGE(PG8_SB(0, 0), b2, voffB);
            PG8_BAR; PG8_WAIT_L(0); PG8_MMA(0, 1, At, B1); PG8_BAR;
            PG8_LDA(At, 0, 1); PG8_STAGE(PG8_SA(0, 0), a2, voffA);
            PG8_BAR; PG8_WAIT_L(0); PG8_MMA(1, 0, At, B0); PG8_BAR; PG8_SCHED;
            PG8_STAGE(PG8_SB(0, 1), b2 + hstep, voffB);
            PG8_WAIT_V(6); PG8_BAR; PG8_MMA(1, 1, At, B1); PG8_BAR;
            PG8_LDB(B0, 1, 0); PG8_SCHED; PG8_LDA(At, 1, 0); PG8_STAGE(PG8_SA(0, 1), a2 + hstep, voffA);
            PG8_WAIT_L(8); PG8_BAR; PG8_WAIT_L(0); PG8_MMA(0, 0, At, B0); PG8_BAR; PG8_SCHED;
            PG8_LDB(B1, 1, 1); PG8_STAGE(PG8_SB(1, 0), b3, voffB);
            PG8_BAR; PG8_WAIT_L(0); PG8_MMA(0, 1, At, B1); PG8_BAR;
            PG8_LDA(At, 1, 1); PG8_STAGE(PG8_SA(1, 0), a3, voffA);
            PG8_BAR; PG8_WAIT_L(0); PG8_MMA(1, 0, At, B0); PG8_BAR; PG8_SCHED;
            PG8_STAGE(PG8_SB(1, 1), b3 + hstep, voffB);
            PG8_WAIT_V(6); PG8_BAR; PG8_MMA(1, 1, At, B1); PG8_BAR;
            }
        }
        if constexpr (ALIGN_EPI) { if (wr == 0) PG8_BAR; }
        if constexpr (!Epi::AFTER_DRAIN) { E(acc, est, cur, wr, wc, fr, fq); S.done(cur); }
        if (!has_next) break;
        E.init(acc, est, nxt, wr, wc, fr, fq);
        cur = nxt; cA = nA; cB = nB; ++ui;
        if constexpr (ALIGN_EPI) { if (wr == 1) PG8_BAR; }
    }
    PG8_WAIT_V(0);
    if constexpr (!ALIGN_EPI) { if (wr == 0) PG8_BAR; }
    PG8_BAR;
    if constexpr (Epi::AFTER_DRAIN) { E.fused(acc, cur, wr, wc, fr, fq, lds, wid, lane); S.done(cur); }
#undef PG8_SA
#undef PG8_SB
#undef PG8_STAGE
#undef PG8_LDA
#undef PG8_LDB
#undef PG8_MMA
#undef PG8_WAIT_V
#undef PG8_WAIT_L
#undef PG8_BAR
#undef PG8_SCHED
}
}
#define GAS __attribute__((address_space(1)))
#define LAS __attribute__((address_space(3)))
typedef unsigned short bf16;
typedef unsigned v4u __attribute__((ext_vector_type(4)));
typedef float f32x4 __attribute__((ext_vector_type(4)));
typedef short bf16x8 __attribute__((ext_vector_type(8)));
typedef GAS unsigned gu32;
typedef GAS unsigned long long gu64;
#define RLX_AGENT __ATOMIC_RELAXED, __HIP_MEMORY_SCOPE_AGENT
#define LDS_WAIT() asm volatile("s_waitcnt lgkmcnt(0)" ::: "memory")
#define VM_WAIT() asm volatile("s_waitcnt vmcnt(0)" ::: "memory")
__device__ __forceinline__ unsigned long long rt() { return __builtin_amdgcn_s_memrealtime(); }
__device__ __forceinline__ unsigned f2bf(float f) { unsigned u = __builtin_bit_cast(unsigned, f); return (u + 0x7fffu + ((u >> 16) & 1u)) >> 16; }
__device__ __forceinline__ unsigned pk2(float lo, float hi) { return pg8::cvt_pk_bf16(lo, hi); }

#define XB_TMO      128
#define XB_XCNT(j)  (256  + 64 * (j))
#define XB_XSUB(j)  (1280 + 64 * (j))
#define XB_XGEN(j)  (2304 + 64 * (j))
#define XB_TOP      3328
#define XB_TOPGEN   3392
#define XCD_BAR_WORDS 3456
#define XB_SPIN_CAP (1u << 18)

__device__ __forceinline__ unsigned xb_ld(unsigned* p)              { return __hip_atomic_load(p, __ATOMIC_RELAXED, __HIP_MEMORY_SCOPE_AGENT); }
__device__ __forceinline__ unsigned xb_add(unsigned* p, unsigned v) { return __hip_atomic_fetch_add(p, v, __ATOMIC_RELAXED, __HIP_MEMORY_SCOPE_AGENT); }
__device__ __forceinline__ unsigned xb_xcc_id() { return (unsigned)__builtin_amdgcn_s_getreg((3 << 11) | 20) & 0xFu; }
#define XB_SPIN(cond, bar) do { unsigned _sp = 0; while (cond) { __builtin_amdgcn_s_sleep(1); \
    if ((++_sp & 255u) == 0u) { if (xb_ld(&(bar)[XB_TMO])) break; if (_sp > XB_SPIN_CAP) { atomicAdd(&(bar)[XB_TMO], 1u); break; } } } } while (0)

struct XcdBarrier {
    unsigned* bar; unsigned x;
    int w;
    volatile LAS unsigned* st;
};

__device__ __forceinline__ XcdBarrier xcd_barrier_post(unsigned* bar, volatile LAS unsigned* st) {
    XcdBarrier b; b.bar = bar; b.x = xb_xcc_id(); b.st = st; b.w = __builtin_amdgcn_readfirstlane((int)threadIdx.x >> 6);
    if (threadIdx.x == 0) (void)xb_add(&bar[XB_XCNT(b.x)], 1u);
    return b;
}
__device__ __forceinline__ void xcd_barrier_complete(unsigned* bar, unsigned x, unsigned& nloc, unsigned& nx) {
    const unsigned G = gridDim.x * gridDim.y * gridDim.z;
    unsigned sum, cnt, mine, sp = 0u;
    for (;;) {
        sum = 0u; cnt = 0u; mine = 0u;
#pragma unroll
        for (unsigned j = 0; j < 16; ++j) { const unsigned c = xb_ld(&bar[XB_XCNT(j)]); sum += c; cnt += (c > 0u) ? 1u : 0u; mine = (j == x) ? c : mine; }
        if (sum == G) break;
        __builtin_amdgcn_s_sleep(1);
        if ((++sp & 255u) == 0u) { if (xb_ld(&bar[XB_TMO])) break; if (sp > XB_SPIN_CAP) { atomicAdd(&bar[XB_TMO], 1u); break; } }
    }
    nloc = mine > 0u ? mine : 1u; nx = cnt > 0u ? cnt : 1u;
}

__device__ __forceinline__ void xcd_barrier(const XcdBarrier& b) {
    asm volatile("s_waitcnt vmcnt(0)" ::: "memory");
    __syncthreads();
    if (b.w == 0 && pg8::lane_id_fresh() == 0) {
        unsigned* bar = b.bar;
        __builtin_amdgcn_s_waitcnt(0);
        unsigned nloc = b.st[0], nx = b.st[1];
        if (nloc == 0u) { xcd_barrier_complete(bar, b.x, nloc, nx); b.st[0] = nloc; b.st[1] = nx; }
        const unsigned old = xb_add(&bar[XB_XSUB(b.x)], 1u);
        const unsigned gen = old / nloc;
        if (old + 1u == (gen + 1u) * nloc) {
            __builtin_amdgcn_fence(__ATOMIC_RELEASE, "agent");
            asm volatile("s_waitcnt vmcnt(0)" ::: "memory");
            const unsigned og = xb_add(&bar[XB_TOP], 1u);
            const unsigned tg = og / nx;
            if (og + 1u == (tg + 1u) * nx) xb_add(&bar[XB_TOPGEN], 1u);
            else XB_SPIN(xb_ld(&bar[XB_TOPGEN]) == tg, bar);
            __builtin_amdgcn_fence(__ATOMIC_ACQUIRE, "agent");
            xb_add(&bar[XB_XGEN(b.x)], 1u);
            asm volatile("s_waitcnt vmcnt(0)" ::: "memory");
        } else {
            XB_SPIN(xb_ld(&bar[XB_XGEN(b.x)]) == gen, bar);
            __builtin_amdgcn_fence(__ATOMIC_ACQUIRE, "agent");
            asm volatile("s_waitcnt vmcnt(0)" ::: "memory");
        }
    }
    __syncthreads();
}

constexpr int NWAVES = 8;
constexpr int BATCH = 8, SEQ = 2048, M = BATCH * SEQ, DEPTH = 4;
constexpr int DM = pg8::DM, DFF = pg8::DFF, NUP = 2 * DFF, INW = pg8::INW;
constexpr int AW = 512, HW = 1024;
using pg8::ZC_QA; using pg8::ZC_KA; using pg8::ZC_VA; using pg8::ZC_QH; using pg8::ZC_FH; using pg8::ZC_IH; using pg8::ZC_GH;
constexpr float RMS_EPS = 1e-6f;
#ifndef MK_ONE_LAUNCH
#define MK_ONE_LAUNCH 1
#endif
constexpr int N_PHASES = 1 + 8 * 2 + 4 * 5 + 1;

constexpr size_t MiB = 1u << 20;
constexpr size_t WS_CTL = 0, CTL_ZERO_BYTES = 4 * MiB;
constexpr size_t WS_ROWSS = 2 * MiB;
constexpr size_t WS_LB = 4 * MiB;
constexpr size_t WS_X = 16 * MiB;
constexpr size_t WS_XB = 144 * MiB;
constexpr size_t WS_HFF = 208 * MiB;
constexpr size_t WS_Z = 384 * MiB;
constexpr size_t WS_LOGF = 784 * MiB;
constexpr size_t WS_ATT = 848 * MiB;
constexpr size_t WS_HG = 864 * MiB;
constexpr size_t WS_Y32 = 896 * MiB;
constexpr size_t WS_YB = 1024 * MiB;
constexpr size_t WS_O32 = 1088 * MiB;
constexpr size_t WS_AO = 1152 * MiB;
constexpr size_t WS_LSE = 1200 * MiB;
constexpr size_t WS_SLOC = 1216 * MiB;
constexpr size_t WS_DTOT = 1249 * MiB;
constexpr size_t WS_W = 1300 * MiB;
constexpr size_t WL_BYTES = 193 * MiB;
constexpr size_t WO_W1 = 0, W1_BYTES = 43 * MiB, WO_W2 = 86 * MiB, W2_BYTES = (size_t)DM * DFF * 2, WO_WIN = 129 * MiB, WO_WPA = 179 * MiB, WO_WPM = 181 * MiB, WO_WO = 185 * MiB;
constexpr size_t WS_END = WS_W + 4 * WL_BYTES;
static_assert((size_t)NUP * DM * 2 == W1_BYTES && 2 * W2_BYTES == 43 * MiB && (size_t)INW * DM * 2 == 50 * MiB, "weight map");
static_assert(WS_HFF + (size_t)M * DFF * 2 <= WS_Z && WS_Z + (size_t)M * INW * 2 <= WS_LOGF, "ws map");
constexpr int CW_BAR = 4096;

constexpr int RING_OFF = 0, RING_BYTES = 131072;
constexpr int LDS_BYTES = 159744;
constexpr int LDSCTL_OFF = LDS_BYTES - 512, MISC_OFF = LDSCTL_OFF + 320;
static_assert(MISC_OFF + 128 <= LDS_BYTES, "LDS map");

__device__ __forceinline__ float wave_sum(float v) {
#pragma unroll
    for (int o = 1; o < 64; o <<= 1) v += __shfl_xor(v, o);
    return v;
}
using pg8::bflo; using pg8::bfhi; using pg8::lane_id_fresh;
typedef float f32x2 __attribute__((ext_vector_type(2)));
using pg8::u32x2;

__device__ __forceinline__ void tr_item(const float* __restrict__ W, int K, int N, bf16* __restrict__ WT, const float* __restrict__ gain, bool ilv, LAS float* scr, int item, int lane) {
    const int nblk = N >> 5, kb = item / nblk, nb = item - kb * nblk, k0 = kb << 6, n0 = nb << 5;
    const int lr = lane >> 3, c4 = (lane & 7) << 2;
#pragma unroll
    for (int i = 0; i < 8; ++i) {
        const int kk = 8 * i + lr;
        const f32x4 v = *(const GAS f32x4*)(W + (size_t)(k0 + kk) * N + n0 + c4);
        const float g = gain ? gain[k0 + kk] : 1.0f;
        LAS float* d = scr + kk * 33 + c4;
        d[0] = v.x * g; d[1] = v.y * g; d[2] = v.z * g; d[3] = v.w * g;
    }
    LDS_WAIT(); asm volatile("" ::: "memory");
    const int c = lane & 7;
#pragma unroll
    for (int j = 0; j < 4; ++j) {
        const int n = (lane >> 3) + 8 * j; const LAS float* s = scr + (8 * c) * 33 + n;
        v4u o; o.x = pk2(s[0 * 33], s[1 * 33]); o.y = pk2(s[2 * 33], s[3 * 33]); o.z = pk2(s[4 * 33], s[5 * 33]); o.w = pk2(s[6 * 33], s[7 * 33]);
        const int col = n0 + n; int drow = col;
        if (ilv) { const int up = col >= DFF ? 1 : 0; const int jj = up ? col - DFF : col; drow = ((jj >> 7) << 8) + (up << 7) + (jj & 127); }
        *(GAS v4u*)(WT + (size_t)drow * K + k0 + 8 * c) = o;
    }
    LDS_WAIT(); asm volatile("" ::: "memory");
}

struct Args { const float* in[13]; float* out; unsigned char* ws; int ph_lo, ph_hi; };
constexpr int I_W1 = (DM / 64) * (NUP / 32), I_W2 = (DFF / 64) * (DM / 32), I_WIN = (DM / 64) * (INW / 32), I_WPA = (AW / 64) * (DM / 32), I_WPM = (HW / 64) * (DM / 32), I_WO = (DM / 64) * (DM / 32);
constexpr int I_LAYER = 2 * I_W1 + 2 * I_W2 + I_WIN + I_WPA + I_WPM + I_WO;
struct ConvSrc { const float *ffn_norm, *ffn_w_in, *ffn_w_out, *mix_norm, *w_in, *w_pa, *w_pm, *w_o; unsigned char* ws; };
__device__ __forceinline__ ConvSrc conv_src() {
    const __attribute__((address_space(4))) Args* ka = (const __attribute__((address_space(4))) Args*)__builtin_amdgcn_kernarg_segment_ptr();
    asm volatile("" : "+s"(ka));
    return ConvSrc{ka->in[1], ka->in[2], ka->in[3], ka->in[4], ka->in[5], ka->in[9], ka->in[10], ka->in[11], ka->ws};
}
__device__ __forceinline__ void conv_item(const ConvSrc& C, int it, LAS float* scr, int lane) {
    const int l = it / I_LAYER; int r = it - l * I_LAYER;
    unsigned char* wl = C.ws + WS_W + (size_t)l * WL_BYTES;
    if (r < 2 * I_W1) { const int s = r >= I_W1 ? 1 : 0; r -= s * I_W1;
        tr_item(C.ffn_w_in + (size_t)(l * 2 + s) * DM * NUP, DM, NUP, (bf16*)(wl + WO_W1 + s * W1_BYTES), C.ffn_norm + (size_t)(l * 2 + s) * DM, true, scr, r, lane); return; }
    r -= 2 * I_W1;
    if (r < 2 * I_W2) { const int s = r >= I_W2 ? 1 : 0; r -= s * I_W2;
        tr_item(C.ffn_w_out + (size_t)(l * 2 + s) * DFF * DM, DFF, DM, (bf16*)(wl + WO_W2 + s * W2_BYTES), nullptr, false, scr, r, lane); return; }
    r -= 2 * I_W2;
    if (r < I_WIN) { tr_item(C.w_in + (size_t)l * DM * INW, DM, INW, (bf16*)(wl + WO_WIN), C.mix_norm + (size_t)l * DM, false, scr, r, lane); return; }
    r -= I_WIN;
    if (r < I_WPA) { tr_item(C.w_pa + (size_t)l * AW * DM, AW, DM, (bf16*)(wl + WO_WPA), nullptr, false, scr, r, lane); return; }
    r -= I_WPA;
    if (r < I_WPM) { tr_item(C.w_pm + (size_t)l * HW * DM, HW, DM, (bf16*)(wl + WO_WPM), nullptr, false, scr, r, lane); return; }
    r -= I_WPM;
    tr_item(C.w_o + (size_t)l * DM * DM, DM, DM, (bf16*)(wl + WO_WO), nullptr, false, scr, r, lane);
}
constexpr int AT_KSTR = 272, AT_VSTR = 528, AT_K_OFF = 0, AT_V_OFF = 256 * AT_KSTR;
static_assert(AT_V_OFF + 128 * AT_VSTR <= LDSCTL_OFF, "attention LDS");
#define AT_BAR() do { asm volatile("s_waitcnt lgkmcnt(0)" ::: "memory"); __builtin_amdgcn_s_barrier(); asm volatile("" ::: "memory"); } while (0)
__device__ __forceinline__ void attn_fast(LAS unsigned char* lds, const bf16* __restrict__ QKV, bf16* __restrict__ AO, float* __restrict__ LSE, int bx, int G, int w) {
    const int lane = lane_id_fresh(), tid = w * 64 + lane, fr = lane & 15, fq = lane >> 4;
    for (int idx = bx; idx < 1536; idx += G) {
        const int g = idx >> 9, rem = idx & 511, b = rem >> 6, h = (rem >> 4) & 3, blk = rem & 15;
        const int sh = 2 * g, nb = 16 >> sh, c = blk >> (4 - sh), n = blk & (nb - 1);
        const int j0 = n > 0 ? 0 : 128;
        const size_t zb = (size_t)b * SEQ;
        const size_t sb = ((size_t)((b * 3 + g) * 4 + h) * SEQ + (size_t)c * (SEQ >> sh)) * 128;
        const bf16* QA = QKV + sb; const bf16* KA = QKV + pg8::QKV_PART + sb; const bf16* VA = QKV + 2 * pg8::QKV_PART + sb;
        const int qi = 16 * w + fr; const size_t qrow = zb + ((size_t)(128 * n + qi) << sh) + c;
        bf16x8 qf[4];
#pragma unroll
        for (int ks = 0; ks < 4; ++ks) qf[ks] = *(const GAS bf16x8*)(QA + (size_t)(128 * n + qi) * 128 + 32 * ks + 8 * fq);
        if (n == 0) {
#pragma unroll
            for (int it = 0; it < 4; ++it) { const int ch = tid + 512 * it, d = ch >> 4, cc = ch & 15; *(LAS v4u*)(lds + AT_V_OFF + d * AT_VSTR + cc * 16) = (v4u){0u, 0u, 0u, 0u}; }
        }
#pragma unroll
        for (int it = 0; it < 8; ++it) {
            const int ch = tid + 512 * it, j = ch >> 4, dc = ch & 15;
            if (j >= j0) {
                const size_t go = (size_t)(128 * (n - 1) + j) * 128 + 8 * dc;
                const v4u kw = *(const GAS v4u*)(KA + go);
                const v4u vw = *(const GAS v4u*)(VA + go);
                *(LAS v4u*)(lds + AT_K_OFF + j * AT_KSTR + dc * 16) = kw;
                LAS unsigned short* vt = (LAS unsigned short*)(lds + AT_V_OFF + (8 * dc) * AT_VSTR) + (j ^ (dc << 2));
                vt[0 * (AT_VSTR / 2)] = (unsigned short)(vw.x & 0xffffu); vt[1 * (AT_VSTR / 2)] = (unsigned short)(vw.x >> 16);
                vt[2 * (AT_VSTR / 2)] = (unsigned short)(vw.y & 0xffffu); vt[3 * (AT_VSTR / 2)] = (unsigned short)(vw.y >> 16);
                vt[4 * (AT_VSTR / 2)] = (unsigned short)(vw.z & 0xffffu); vt[5 * (AT_VSTR / 2)] = (unsigned short)(vw.z >> 16);
                vt[6 * (AT_VSTR / 2)] = (unsigned short)(vw.w & 0xffffu); vt[7 * (AT_VSTR / 2)] = (unsigned short)(vw.w >> 16);
            }
        }
        AT_BAR();
        const int tl0 = n > 0 ? 0 : 8 - w;
        f32x4 st[9];
#pragma unroll
        for (int tl = 0; tl < 9; ++tl) {
            st[tl] = (f32x4){0.f, 0.f, 0.f, 0.f};
            if (tl >= tl0) {
                const int kt = w + tl;
#pragma unroll
                for (int ks = 0; ks < 4; ++ks) { const bf16x8 a = *(const LAS bf16x8*)(lds + AT_K_OFF + (16 * kt + fr) * AT_KSTR + (32 * ks + 8 * fq) * 2); st[tl] = __builtin_amdgcn_mfma_f32_16x16x32_bf16(a, qf[ks], st[tl], 0, 0, 0); }
            }
        }
        float mx = -1e30f;
#pragma unroll
        for (int tl = 0; tl < 9; ++tl)
#pragma unroll
            for (int i = 0; i < 4; ++i) { const int dlt = 16 * tl + 4 * fq + i - fr; const bool valid = (dlt >= 0) && (dlt <= 128) && (tl >= tl0); const float sv = valid ? st[tl][i] : -1e30f; st[tl][i] = sv; mx = fmaxf(mx, sv); }
        mx = fmaxf(mx, __shfl_xor(mx, 16)); mx = fmaxf(mx, __shfl_xor(mx, 32));
        float l = 0.f;
#pragma unroll
        for (int tl = 0; tl < 9; ++tl)
#pragma unroll
            for (int i = 0; i < 4; ++i) { const float pv = __builtin_amdgcn_exp2f(st[tl][i] - mx); st[tl][i] = pv; l += pv; }
        l += __shfl_xor(l, 16); l += __shfl_xor(l, 32);
        f32x4 o[8];
#pragma unroll
        for (int dt = 0; dt < 8; ++dt) o[dt] = (f32x4){0.f, 0.f, 0.f, 0.f};
#pragma unroll
        for (int p = 0; p < 5; ++p) {
            if (2 * p + 1 >= tl0) {
                v4u pw; pw.x = pk2(st[2 * p][0], st[2 * p][1]); pw.y = pk2(st[2 * p][2], st[2 * p][3]);
                if (p < 4) { pw.z = pk2(st[(2 * p + 1) % 9][0], st[(2 * p + 1) % 9][1]); pw.w = pk2(st[(2 * p + 1) % 9][2], st[(2 * p + 1) % 9][3]); } else { pw.z = 0u; pw.w = 0u; }
                const bf16x8 pb = __builtin_bit_cast(bf16x8, pw);
                const int kta = w + 2 * p, ktb = (w + 2 * p + 1) < 15 ? (w + 2 * p + 1) : 15;
#pragma unroll
                for (int dt = 0; dt < 8; ++dt) {
                    const int d = 16 * dt + fr, swz = (2 * dt + (fr >> 3)) << 2;
                    const u32x2 lo = *(const LAS u32x2*)(lds + AT_V_OFF + d * AT_VSTR + 2 * ((16 * kta + 4 * fq) ^ swz));
                    const u32x2 hi = *(const LAS u32x2*)(lds + AT_V_OFF + d * AT_VSTR + 2 * ((16 * ktb + 4 * fq) ^ swz));
                    const bf16x8 va = __builtin_bit_cast(bf16x8, (v4u){lo.x, lo.y, hi.x, hi.y});
                    o[dt] = __builtin_amdgcn_mfma_f32_16x16x32_bf16(va, pb, o[dt], 0, 0, 0);
                }
            }
        }
        const float inv = 1.0f / l;
        bf16* orow = AO + ((size_t)g * M + qrow) * AW + h * 128 + 4 * fq;
#pragma unroll
        for (int dt = 0; dt < 8; ++dt) { u32x2 ov; ov.x = pk2(o[dt][0] * inv, o[dt][1] * inv); ov.y = pk2(o[dt][2] * inv, o[dt][3] * inv); *(GAS u32x2*)(orow + 16 * dt) = ov; }
        if (fq == 0) LSE[((size_t)g * M + qrow) * 4 + h] = mx + __builtin_amdgcn_logf(l);
        AT_BAR();
    }
}
__device__ __forceinline__ void attn_combine(const bf16* __restrict__ AO, const float* __restrict__ LSE, bf16* __restrict__ ATT, int gw, int NGW) {
    const int lane = lane_id_fresh();
    for (int idx = gw * 64 + lane; idx < M * 64; idx += NGW * 64) {
        const int row = idx >> 6, h = (idx >> 4) & 3, dc = idx & 15;
        const float l0 = LSE[(size_t)row * 4 + h], l1 = LSE[((size_t)M + row) * 4 + h], l2 = LSE[((size_t)2 * M + row) * 4 + h];
        const float mx = fmaxf(l0, fmaxf(l1, l2));
        float w0 = __builtin_amdgcn_exp2f(l0 - mx), w1 = __builtin_amdgcn_exp2f(l1 - mx), w2 = __builtin_amdgcn_exp2f(l2 - mx);
        const float inv = 1.0f / (w0 + w1 + w2); w0 *= inv; w1 *= inv; w2 *= inv;
        const size_t off = (size_t)row * AW + h * 128 + 8 * dc;
        const v4u a = *(const GAS v4u*)(AO + off), b = *(const GAS v4u*)(AO + (size_t)M * AW + off), c = *(const GAS v4u*)(AO + (size_t)2 * M * AW + off);
        v4u r;
        r.x = pk2(w0 * bflo(a.x) + w1 * bflo(b.x) + w2 * bflo(c.x), w0 * bfhi(a.x) + w1 * bfhi(b.x) + w2 * bfhi(c.x));
        r.y = pk2(w0 * bflo(a.y) + w1 * bflo(b.y) + w2 * bflo(c.y), w0 * bfhi(a.y) + w1 * bfhi(b.y) + w2 * bfhi(c.y));
        r.z = pk2(w0 * bflo(a.z) + w1 * bflo(b.z) + w2 * bflo(c.z), w0 * bfhi(a.z) + w1 * bfhi(b.z) + w2 * bfhi(c.z));
        r.w = pk2(w0 * bflo(a.w) + w1 * bflo(b.w) + w2 * bflo(c.w), w0 * bfhi(a.w) + w1 * bfhi(b.w) + w2 * bfhi(c.w));
        *(GAS v4u*)(ATT + off) = r;
    }
}

constexpr int HB_STR = 132 * 4, HQ_STR = 264, HQT_STR = 272, HKB_STR = 144, HP_STR = 40;
constexpr int HB_OFF = 0, HQ_OFF = HB_OFF + 64 * HB_STR, HK_OFF = HQ_OFF + 64 * HQ_STR, HQT_OFF = HK_OFF + 64 * HQ_STR, HKB_OFF = HQT_OFF + 64 * HQT_STR, HVT_OFF = HKB_OFF + 128 * HKB_STR,
              HP_OFF = HVT_OFF + 128 * HKB_STR, HD_OFF = HP_OFF + 64 * HP_STR, HBL_OFF = HD_OFF + 2048, H_END = HBL_OFF + 2048;
static_assert(H_END <= LDSCTL_OFF && HQ_OFF % 16 == 0 && HK_OFF % 16 == 0 && HQT_OFF % 16 == 0 && HKB_OFF % 16 == 0 && HVT_OFF % 16 == 0 && HP_OFF % 16 == 0 && HD_OFF % 16 == 0, "hgrn LDS");
typedef short s16x4 __attribute__((ext_vector_type(4)));
#define HG_BAR() do { asm volatile("s_waitcnt lgkmcnt(0)" ::: "memory"); __builtin_amdgcn_s_barrier(); asm volatile("" ::: "memory"); } while (0)
template <bool FULL>
__device__ __forceinline__ void hgrn_pass(LAS unsigned char* lds, const bf16* __restrict__ HBF, const float* __restrict__ LOGF, const float* __restrict__ hnorm, float* __restrict__ SLOC, float* __restrict__ DTOT,
                                          bf16* __restrict__ HG, int bx, int G, int w) {
    const int lane = lane_id_fresh(), tid = w * 64 + lane, fr = lane & 15, fq = lane >> 4;
    const int J1 = tid >> 7, k1 = tid & 127;
    constexpr int NITEM = FULL ? 512 : 448;
    for (int idx = bx; idx < NITEM; idx += G) {
        const int bh = FULL ? (idx >> 3) : (idx / 7), sc = FULL ? ((idx & 256) ? 7 - (idx & 7) : (idx & 7)) : (idx - 7 * (idx / 7)), b = bh >> 3, h = bh & 7;
        const size_t row0 = (size_t)bh * SEQ + (size_t)sc * 256;
        const bf16* HQ = HBF; const bf16* HKEY = HBF + pg8::HB_PART; const bf16* HI = HBF + 2 * pg8::HB_PART; const bf16* HGT = HBF + 3 * pg8::HB_PART;
        f32x4 S[8];
#pragma unroll
        for (int kt = 0; kt < 8; ++kt) S[kt] = (f32x4){0.f, 0.f, 0.f, 0.f};
        if (FULL) {
            for (int m = 0; m < sc; ++m) {
                const float* dt = DTOT + (size_t)(bh * 8 + m) * 128; const float* sl = SLOC + ((size_t)(bh * 8 + m) * 64 + w * 8) * 256 + lane * 4;
#pragma unroll
                for (int kt = 0; kt < 8; ++kt) { const f32x4 dv = *(const GAS f32x4*)(dt + 16 * kt + 4 * fq); const f32x4 sv = *(const GAS f32x4*)(sl + kt * 256); S[kt] = S[kt] * dv + sv; }
            }
        }
        float dsum = 0.f;
        float lf[16]; unsigned kr[16], vr[16], qr[16];
#define HG_LOAD(chn) do { const size_t rJ_ = row0 + 64 * (chn) + 16 * J1; \
        _Pragma("unroll") for (int t = 0; t < 16; ++t) { lf[t] = LOGF[(rJ_ + t) * 128 + k1]; kr[t] = *(const GAS unsigned short*)(HKEY + (rJ_ + t) * 128 + k1); vr[t] = *(const GAS unsigned short*)(HI + (rJ_ + t) * 128 + k1); \
            if (FULL) qr[t] = *(const GAS unsigned short*)(HQ + (rJ_ + t) * 128 + k1); } } while (0)
        HG_LOAD(0);
#pragma unroll 1
        for (int ch = 0; ch < 4; ++ch) {
            const size_t crow0 = row0 + 64 * ch;
            {
                float bb[16]; float run = 0.f;
#pragma unroll
                for (int t = 0; t < 16; ++t) { run += lf[t]; bb[t] = run; }
                unsigned kbw[8], ivw[8];
#pragma unroll
                for (int t = 0; t < 16; t += 2) {
                    const float kfa = __uint_as_float(kr[t] << 16), kfb = __uint_as_float(kr[t + 1] << 16);
                    kbw[t >> 1] = pk2(kfa * __builtin_amdgcn_exp2f(run - bb[t]), kfb * __builtin_amdgcn_exp2f(run - bb[t + 1]));
                    ivw[t >> 1] = vr[t] | (vr[t + 1] << 16);
                    if (FULL) {
                        const float qfa = __uint_as_float(qr[t] << 16), qfb = __uint_as_float(qr[t + 1] << 16);
                        const int ta = 16 * J1 + t;
                        *(LAS float*)(lds + HB_OFF + ta * HB_STR + k1 * 4) = bb[t]; *(LAS float*)(lds + HB_OFF + (ta + 1) * HB_STR + k1 * 4) = bb[t + 1];
                        *(LAS unsigned short*)(lds + HQ_OFF + ta * HQ_STR + k1 * 2) = (unsigned short)qr[t]; *(LAS unsigned short*)(lds + HQ_OFF + (ta + 1) * HQ_STR + k1 * 2) = (unsigned short)qr[t + 1];
                        *(LAS unsigned short*)(lds + HK_OFF + ta * HQ_STR + k1 * 2) = (unsigned short)kr[t]; *(LAS unsigned short*)(lds + HK_OFF + (ta + 1) * HQ_STR + k1 * 2) = (unsigned short)kr[t + 1];
                        const unsigned qtw = pk2(qfa * __builtin_amdgcn_exp2f(bb[t]), qfb * __builtin_amdgcn_exp2f(bb[t + 1]));
                        *(LAS unsigned short*)(lds + HQT_OFF + ta * HQT_STR + k1 * 2) = (unsigned short)(qtw & 0xffffu);
                        *(LAS unsigned short*)(lds + HQT_OFF + (ta + 1) * HQT_STR + k1 * 2) = (unsigned short)(qtw >> 16);
                    }
                }
                *(LAS v4u*)(lds + HKB_OFF + k1 * HKB_STR + J1 * 32) = (v4u){kbw[0], kbw[1], kbw[2], kbw[3]}; *(LAS v4u*)(lds + HKB_OFF + k1 * HKB_STR + J1 * 32 + 16) = (v4u){kbw[4], kbw[5], kbw[6], kbw[7]};
                *(LAS v4u*)(lds + HVT_OFF + k1 * HKB_STR + J1 * 32) = (v4u){ivw[0], ivw[1], ivw[2], ivw[3]}; *(LAS v4u*)(lds + HVT_OFF + k1 * HKB_STR + J1 * 32 + 16) = (v4u){ivw[4], ivw[5], ivw[6], ivw[7]};
                *(LAS float*)(lds + HD_OFF + (J1 * 128 + k1) * 4) = __builtin_amdgcn_exp2f(run);
                if (!FULL) *(LAS float*)(lds + HBL_OFF + (J1 * 128 + k1) * 4) = run;
                if (FULL && tid < 160) *(LAS v4u*)(lds + HP_OFF + tid * 16) = (v4u){0u, 0u, 0u, 0u};
            }
            if (ch < 3) HG_LOAD(ch + 1);
            v4u g0, g1;
            if (FULL) { const bf16* gp = HGT + (crow0 + (tid >> 3)) * 128 + 16 * (tid & 7); g0 = *(const GAS v4u*)gp; g1 = *(const GAS v4u*)(gp + 8); }
            HG_BAR();
            if (FULL) {
#pragma unroll 1
                for (int rr = 0; rr < 3; ++rr) {
                    const int hp = tid + 512 * rr;
                    if (rr < 2 || w == 0) {
                        const int pr = hp >> 1, half = hp & 1, J = pr / 136, pp = pr - 136 * J;
                        int t = (int)((__builtin_sqrtf(8.0f * (float)pp + 1.0f) - 1.0f) * 0.5f);
                        if ((t + 1) * (t + 2) / 2 <= pp) ++t;
                        if (t * (t + 1) / 2 > pp) --t;
                        const int s2 = pp - t * (t + 1) / 2;
                        const LAS unsigned char* bt = lds + HB_OFF + (16 * J + t) * HB_STR + half * 256; const LAS unsigned char* bs = lds + HB_OFF + (16 * J + s2) * HB_STR + half * 256;
                        const LAS unsigned char* qp = lds + HQ_OFF + (16 * J + t) * HQ_STR + half * 128; const LAS unsigned char* kp = lds + HK_OFF + (16 * J + s2) * HQ_STR + half * 128;
                        float a0 = 0.f, a1 = 0.f;
#pragma unroll 4
                        for (int kk = 0; kk < 16; ++kk) {
                            const f32x4 b1 = *(const LAS f32x4*)(bt + kk * 16), b2 = *(const LAS f32x4*)(bs + kk * 16);
                            const u32x2 qw = *(const LAS u32x2*)(qp + kk * 8), kw = *(const LAS u32x2*)(kp + kk * 8);
                            a0 += bflo(qw.x) * bflo(kw.x) * __builtin_amdgcn_exp2f(b1[0] - b2[0]); a1 += bfhi(qw.x) * bfhi(kw.x) * __builtin_amdgcn_exp2f(b1[1] - b2[1]);
                            a0 += bflo(qw.y) * bflo(kw.y) * __builtin_amdgcn_exp2f(b1[2] - b2[2]); a1 += bfhi(qw.y) * bfhi(kw.y) * __builtin_amdgcn_exp2f(b1[3] - b2[3]);
                        }
                        float a = a0 + a1; a += __shfl_xor(a, 1);
                        if (half == 0) *(LAS unsigned short*)(lds + HP_OFF + (16 * J + t) * HP_STR + s2 * 2) = (unsigned short)(pk2(a, 0.f) & 0xffffu);
                    }
                }
                HG_BAR();
            }
#pragma unroll 1
            for (int J = 0; J < 4; ++J) {
                const s16x4 vb = *(const LAS s16x4*)(lds + HVT_OFF + (16 * w + fr) * HKB_STR + (16 * J + 4 * fq) * 2);
                if (FULL) {
                    f32x4 o = (f32x4){0.f, 0.f, 0.f, 0.f};
#pragma unroll
                    for (int kk = 0; kk < 4; ++kk) {
                        const LAS unsigned char* qr = lds + HQT_OFF + (16 * J + fr) * HQT_STR + (32 * kk + 4 * fq) * 2;
                        const u32x2 lo = *(const LAS u32x2*)qr, hi = *(const LAS u32x2*)(qr + 32);
                        const bf16x8 qa = __builtin_bit_cast(bf16x8, (v4u){lo.x, lo.y, hi.x, hi.y});
                        v4u sw; sw.x = pk2(S[2 * kk][0], S[2 * kk][1]); sw.y = pk2(S[2 * kk][2], S[2 * kk][3]); sw.z = pk2(S[2 * kk + 1][0], S[2 * kk + 1][1]); sw.w = pk2(S[2 * kk + 1][2], S[2 * kk + 1][3]);
                        o = __builtin_amdgcn_mfma_f32_16x16x32_bf16(qa, __builtin_bit_cast(bf16x8, sw), o, 0, 0, 0);
                    }
                    const s16x4 pa = *(const LAS s16x4*)(lds + HP_OFF + (16 * J + fr) * HP_STR + 4 * fq * 2);
                    o = __builtin_amdgcn_mfma_f32_16x16x16bf16_1k(pa, vb, o, 0, 0, 0);
#pragma unroll
                    for (int i = 0; i < 4; ++i) *(LAS float*)(lds + HB_OFF + (16 * J + 4 * fq + i) * HB_STR + (16 * w + fr) * 4) = o[i];
                }
#pragma unroll
                for (int kt = 0; kt < 8; ++kt) {
                    const f32x4 dv = *(const LAS f32x4*)(lds + HD_OFF + (J * 128 + 16 * kt + 4 * fq) * 4);
                    const s16x4 ka = *(const LAS s16x4*)(lds + HKB_OFF + (16 * kt + fr) * HKB_STR + (16 * J + 4 * fq) * 2);
                    S[kt] = __builtin_amdgcn_mfma_f32_16x16x16bf16_1k(ka, vb, S[kt] * dv, 0, 0, 0);
                }
            }
            if (!FULL && tid < 128) dsum += (*(const LAS float*)(lds + HBL_OFF + tid * 4) + *(const LAS float*)(lds + HBL_OFF + (128 + tid) * 4)) + (*(const LAS float*)(lds + HBL_OFF + (256 + tid) * 4) + *(const LAS float*)(lds + HBL_OFF + (384 + tid) * 4));
            HG_BAR();
            if (FULL) {
                const int t = tid >> 3, vg = tid & 7;
                const LAS unsigned char* op = lds + HB_OFF + t * HB_STR + vg * 64;
                f32x4 ov[4]; float ss = 0.f;
#pragma unroll
                for (int q4 = 0; q4 < 4; ++q4) { ov[q4] = *(const LAS f32x4*)(op + q4 * 16); ss += (ov[q4][0] * ov[q4][0] + ov[q4][1] * ov[q4][1]) + (ov[q4][2] * ov[q4][2] + ov[q4][3] * ov[q4][3]); }
                ss += __shfl_xor(ss, 1); ss += __shfl_xor(ss, 2); ss += __shfl_xor(ss, 4);
                const float r = __builtin_amdgcn_rsqf(ss * (1.0f / 128.0f) + RMS_EPS);
                const float* np = hnorm + 16 * vg;
                const f32x4 n0 = *(const GAS f32x4*)np, n1 = *(const GAS f32x4*)(np + 4), n2 = *(const GAS f32x4*)(np + 8), n3 = *(const GAS f32x4*)(np + 12);
                v4u r0, r1;
                r0.x = pk2(ov[0][0] * r * n0[0] * bflo(g0.x), ov[0][1] * r * n0[1] * bfhi(g0.x)); r0.y = pk2(ov[0][2] * r * n0[2] * bflo(g0.y), ov[0][3] * r * n0[3] * bfhi(g0.y));
                r0.z = pk2(ov[1][0] * r * n1[0] * bflo(g0.z), ov[1][1] * r * n1[1] * bfhi(g0.z)); r0.w = pk2(ov[1][2] * r * n1[2] * bflo(g0.w), ov[1][3] * r * n1[3] * bfhi(g0.w));
                r1.x = pk2(ov[2][0] * r * n2[0] * bflo(g1.x), ov[2][1] * r * n2[1] * bfhi(g1.x)); r1.y = pk2(ov[2][2] * r * n2[2] * bflo(g1.y), ov[2][3] * r * n2[3] * bfhi(g1.y));
                r1.z = pk2(ov[3][0] * r * n3[0] * bflo(g1.z), ov[3][1] * r * n3[1] * bfhi(g1.z)); r1.w = pk2(ov[3][2] * r * n3[2] * bflo(g1.w), ov[3][3] * r * n3[3] * bfhi(g1.w));
                bf16* hp2 = HG + ((size_t)b * SEQ + (size_t)sc * 256 + 64 * ch + t) * HW + h * 128 + 16 * vg;
                *(GAS v4u*)hp2 = r0; *(GAS v4u*)(hp2 + 8) = r1;
                HG_BAR();
            }
        }
        if (!FULL) {
            float* sl = SLOC + ((size_t)(bh * 8 + sc) * 64 + w * 8) * 256 + lane * 4;
#pragma unroll
            for (int kt = 0; kt < 8; ++kt) *(GAS f32x4*)(sl + kt * 256) = S[kt];
            if (tid < 128) DTOT[(size_t)(bh * 8 + sc) * 128 + tid] = __builtin_amdgcn_exp2f(dsum);
        }
    }
}
typedef const __attribute__((address_space(4))) Args* KArgs;
__device__ __forceinline__ KArgs kargs() { KArgs ka = (KArgs)__builtin_amdgcn_kernarg_segment_ptr(); asm volatile("" : "+s"(ka)); return ka; }
__global__ void __launch_bounds__(NWAVES * 64, 2) mk_fwd(Args args) {
    extern __shared__ __attribute__((aligned(16))) unsigned char lds_raw[];
    LAS unsigned char* lds = (LAS unsigned char*)lds_raw;
    const int wave = __builtin_amdgcn_readfirstlane((int)threadIdx.x >> 6);
    const int G = gridDim.x; const int bx = blockIdx.x;
    const int vcu = (G % 8 == 0) ? (bx % 8) * (G / 8) + bx / 8 : bx;
    const int gw = vcu * NWAVES + wave, NGW = G * NWAVES;
    for (int u = wave * 64 + lane_id_fresh(); u < (LDS_BYTES - LDSCTL_OFF) / 4; u += NWAVES * 64) ((LAS unsigned*)(lds + LDSCTL_OFF))[u] = 0u;
    __syncthreads();
    const int lo = args.ph_lo, hi = args.ph_hi;
    XcdBarrier bar; bar.bar = (unsigned*)(args.ws + WS_CTL) + CW_BAR; bar.x = 0; bar.st = nullptr; bar.w = wave;
    if (hi - lo > 1) bar = xcd_barrier_post((unsigned*)(args.ws + WS_CTL) + CW_BAR, (volatile LAS unsigned*)(lds + MISC_OFF) + 8);
#define IN(k) (lo <= (k) && (k) < hi)
#define SEAM() do { if (IN(ph) && IN(ph + 1)) xcd_barrier(bar); ++ph; } while (0)
#define WSP(T, off) ((T*)(ws + (off)))
    int ph = 0;

    if (IN(ph)) {
        const KArgs ka = kargs(); unsigned char* ws = ka->ws; const float* x_in = ka->in[0]; const float* hgrn_lb = ka->in[7];
        pg8::ss_t* ROWSS = WSP(pg8::ss_t, WS_ROWSS); float* LB = WSP(float, WS_LB); bf16* XB = WSP(bf16, WS_XB);
        const int lane = lane_id_fresh();
        LAS float* scr = (LAS float*)(lds + RING_OFF + wave * 16384);
        const ConvSrc CS = conv_src();
        for (int it = gw; it < DEPTH * I_LAYER; it += NGW) conv_item(CS, it, scr, lane);
        for (int row = gw; row < M; row += NGW) {
            const GAS f32x4* xr = (const GAS f32x4*)(x_in + (size_t)row * DM) + lane;
            GAS unsigned long long* xb8 = (GAS unsigned long long*)(XB + (size_t)row * DM) + lane;
            f32x4 v[8]; float s = 0.f;
#pragma unroll
            for (int j = 0; j < 8; ++j) { v[j] = xr[64 * j]; s += (v[j].x * v[j].x + v[j].y * v[j].y) + (v[j].z * v[j].z + v[j].w * v[j].w); }
            s = wave_sum(s);
#pragma unroll
            for (int j = 0; j < 8; ++j) { xb8[64 * j] = (unsigned long long)pk2(v[j].x, v[j].y) | ((unsigned long long)pk2(v[j].z, v[j].w) << 32); }
            if (lane == 0) ROWSS[row] = pg8::ss_fix(s);
        }
        for (int c = gw * 64 + lane; c < 1024; c += NGW * 64) {
            const float a0 = hgrn_lb[c], a1 = hgrn_lb[1024 + c], a2 = hgrn_lb[2048 + c], a3 = hgrn_lb[3072 + c];
            const float mx = fmaxf(fmaxf(a0, a1), fmaxf(a2, a3));
            const float e0 = __expf(a0 - mx), e1 = __expf(a1 - mx), e2 = __expf(a2 - mx), e3 = __expf(a3 - mx);
            const float inv = 1.0f / (e0 + e1 + e2 + e3);
            LB[c] = 0.f; LB[1024 + c] = e1 * inv; LB[2048 + c] = (e1 + e2) * inv; LB[3072 + c] = (e1 + e2 + e3) * inv;
        }
    }
    SEAM();

    for (int i = 0; i < 8; ++i) {
        const int l = i >> 1, s = i & 1;
        {
            if (IN(ph)) {
                unsigned char* ws = kargs()->ws; unsigned char* wl = ws + WS_W + (size_t)l * WL_BYTES;
                pg8::Gemm g{WSP(bf16, WS_XB), (const bf16*)(wl + WO_W1 + s * W1_BYTES), M, NUP, DM}; pg8::StaticOrder S; S.init(M, NUP, G, bx);
                pg8::EpiFfnUp E{WSP(bf16, WS_HFF), WSP(pg8::ss_t, WS_ROWSS) + (size_t)(3 * l + 2 * s) * M};
                pg8::gemm_phase<pg8::EpiFfnUp, pg8::StaticOrder, true, true>(lds + RING_OFF, g, S, E, wave);
            }
            SEAM();
            if (IN(ph)) {
                unsigned char* ws = kargs()->ws; unsigned char* wl = ws + WS_W + (size_t)l * WL_BYTES;
                pg8::Gemm g{WSP(bf16, WS_HFF), (const bf16*)(wl + WO_W2 + s * W2_BYTES), M, DM, DFF}; pg8::StaticOrder S; S.init(M, DM, G, bx);
                pg8::EpiResid E{WSP(bf16, WS_XB), WSP(pg8::ss_t, WS_ROWSS) + (size_t)(3 * l + 2 * s + 1) * M, 0.5f, 2.0f};
                pg8::gemm_phase<pg8::EpiResid, pg8::StaticOrder, true, true>(lds + RING_OFF, g, S, E, wave);
            }
            SEAM();
        }
        if (s == 0) {
            if (IN(ph)) {
                const KArgs ka = kargs(); unsigned char* ws = ka->ws; unsigned char* wl = ws + WS_W + (size_t)l * WL_BYTES;
                pg8::Gemm g{WSP(bf16, WS_XB), (const bf16*)(wl + WO_WIN), M, INW, DM}; pg8::StaticOrder S; S.init(M, INW, G, bx);
                pg8::EpiZ E{WSP(bf16, WS_Z), WSP(bf16, WS_Z + 144 * MiB), WSP(unsigned char, WS_Z + 272 * MiB), WSP(float, WS_LOGF), WSP(pg8::ss_t, WS_ROWSS) + (size_t)(3 * l + 1) * M, WSP(float, WS_LB) + l * 1024, ka->in[6] + (size_t)l * 2 * DM};
                pg8::gemm_phase<pg8::EpiZ, pg8::StaticOrder, true, true>(lds + RING_OFF, g, S, E, wave);
            }
            SEAM();
            if (IN(ph)) {
                unsigned char* ws = kargs()->ws;
                hgrn_pass<false>(lds, WSP(bf16, WS_Z + 144 * MiB), WSP(float, WS_LOGF), nullptr, WSP(float, WS_SLOC), WSP(float, WS_DTOT), nullptr, bx, G, wave);
                attn_fast(lds, WSP(bf16, WS_Z), WSP(bf16, WS_AO), WSP(float, WS_LSE), bx, G, wave);
            }
            SEAM();
            if (IN(ph)) {
                const KArgs ka = kargs(); unsigned char* ws = ka->ws;
                hgrn_pass<true>(lds, WSP(bf16, WS_Z + 144 * MiB), WSP(float, WS_LOGF), ka->in[8] + l * 128, WSP(float, WS_SLOC), WSP(float, WS_DTOT), WSP(bf16, WS_HG), bx, G, wave);
                attn_combine(WSP(bf16, WS_AO), WSP(float, WS_LSE), WSP(bf16, WS_ATT), gw, NGW);
            }
            SEAM();
            if (IN(ph)) {
                unsigned char* ws = kargs()->ws; unsigned char* wl = ws + WS_W + (size_t)l * WL_BYTES;
                { pg8::Gemm g{WSP(bf16, WS_ATT), (const bf16*)(wl + WO_WPA), M, DM, AW}; pg8::StaticOrder S; S.init(M, DM, G, bx);
                  pg8::EpiPa E{WSP(unsigned char, WS_Z + 272 * MiB), WSP(bf16, WS_Y32)};
                  pg8::gemm_phase<pg8::EpiPa, pg8::StaticOrder, true, true>(lds + RING_OFF, g, S, E, wave); }
                { pg8::Gemm g{WSP(bf16, WS_HG), (const bf16*)(wl + WO_WPM), M, DM, HW}; pg8::StaticOrder S; S.init(M, DM, G, bx);
                  pg8::EpiPm E{WSP(unsigned char, WS_Z + 272 * MiB), WSP(bf16, WS_Y32), WSP(bf16, WS_YB)};
                  pg8::gemm_phase<pg8::EpiPm, pg8::StaticOrder, true, true>(lds + RING_OFF, g, S, E, wave); }
            }
            SEAM();
            if (IN(ph)) {
                unsigned char* ws = kargs()->ws; unsigned char* wl = ws + WS_W + (size_t)l * WL_BYTES;
                pg8::Gemm g{WSP(bf16, WS_YB), (const bf16*)(wl + WO_WO), M, DM, DM}; pg8::StaticOrder S; S.init(M, DM, G, bx);
                pg8::EpiResid E{WSP(bf16, WS_XB), WSP(pg8::ss_t, WS_ROWSS) + (size_t)(3 * l + 2) * M, 1.0f, 1.0f};
                pg8::gemm_phase<pg8::EpiResid, pg8::StaticOrder, true, true>(lds + RING_OFF, g, S, E, wave);
            }
            SEAM();
        }
    }
    if (IN(ph)) {
        const KArgs ka = kargs(); unsigned char* ws = ka->ws; const float* final_norm = ka->in[12]; float* out = ka->out;
        const int lane = lane_id_fresh();
        const pg8::ss_t* rs = WSP(pg8::ss_t, WS_ROWSS) + (size_t)12 * M; const bf16* XB = WSP(bf16, WS_XB);
        for (int row = gw; row < M; row += NGW) {
            const float r = pg8::rstd_of(rs[row]);
            const GAS u32x2* xr = (const GAS u32x2*)(XB + (size_t)row * DM) + lane;
            const GAS f32x4* gn = (const GAS f32x4*)final_norm + lane;
            GAS f32x4* orow = (GAS f32x4*)(out + (size_t)row * DM) + lane;
#pragma unroll
            for (int j = 0; j < 8; ++j) { const u32x2 v = xr[64 * j]; const f32x4 g = gn[64 * j]; orow[64 * j] = (f32x4){bflo(v.x) * r * g.x, bfhi(v.x) * r * g.y, bflo(v.y) * r * g.z, bfhi(v.y) * r * g.w}; }
        }
    }
#undef IN
#undef SEAM
#undef WSP
}

extern "C" void kernel_launch(void* const* d_in, const int* in_sizes, int n_in, void* d_out, int out_size, void* d_ws, size_t ws_size, hipStream_t stream) {
    static int grid = 0;
    if (grid == 0) {
        if (n_in != 13 || in_sizes[0] != M * DM || out_size != M * DM || ws_size < WS_END) { fprintf(stderr, "kernel_launch: unexpected shapes (n_in %d, in0 %d, out %d, ws %zu < %zu?); nothing launched\n", n_in, n_in > 0 ? in_sizes[0] : -1, out_size, ws_size, (size_t)WS_END); grid = -1; return; }
        int dev = 0, cus = 0, per_cu = 0;
        if (hipGetDevice(&dev) != hipSuccess || hipDeviceGetAttribute(&cus, hipDeviceAttributeMultiprocessorCount, dev) != hipSuccess) { grid = -1; return; }
        if (hipFuncSetAttribute((const void*)mk_fwd, hipFuncAttributeMaxDynamicSharedMemorySize, LDS_BYTES) != hipSuccess) { fprintf(stderr, "kernel_launch: hipFuncSetAttribute failed\n"); grid = -1; return; }
        if (hipOccupancyMaxActiveBlocksPerMultiprocessor(&per_cu, (const void*)mk_fwd, NWAVES * 64, LDS_BYTES) != hipSuccess || per_cu < 1) { fprintf(stderr, "kernel_launch: occupancy query says %d blocks per CU\n", per_cu); }
        (void)hipGetLastError();
        grid = cus;
    }
    if (grid < 0) return;
    if (hipMemsetAsync((char*)d_ws + WS_CTL, 0, CTL_ZERO_BYTES, stream) != hipSuccess) { fprintf(stderr, "kernel_launch: memset failed\n"); return; }
    Args a{};
    for (int i = 0; i < 13; ++i) a.in[i] = (const float*)d_in[i];
    a.out = (float*)d_out; a.ws = (unsigned char*)d_ws;
#if MK_ONE_LAUNCH
    a.ph_lo = 0; a.ph_hi = N_PHASES;
    hipLaunchKernelGGL(mk_fwd, dim3(grid), dim3(NWAVES * 64), LDS_BYTES, stream, a);
#else
    for (int p = 0; p < N_PHASES; ++p) { a.ph_lo = p; a.ph_hi = p + 1; hipLaunchKernelGGL(mk_fwd, dim3(grid), dim3(NWAVES * 64), LDS_BYTES, stream, a); }
#endif
    const hipError_t le = hipPeekAtLastError();
    if (le != hipSuccess) fprintf(stderr, "kernel_launch: launch failed: %s\n", hipGetErrorName(le));
}
```

```cpp
#include <hip/hip_runtime.h>
#include <cstdio>
#include <cstdint>
namespace pg8 {
#define PG8_LAS __attribute__((address_space(3)))
typedef unsigned short bf16_t;
typedef short bf16x8 __attribute__((ext_vector_type(8)));
typedef float f32x4 __attribute__((ext_vector_type(4)));
typedef unsigned u32x4 __attribute__((ext_vector_type(4)));
constexpr int BM = 256, BK = 64, HALF = 128, HTB = HALF * BK * 2  , STAGE_BYTES = 8 * HTB, NXCD = 8, WGM = 8;

__host__ __device__ __forceinline__ int lds_byte(int r, int c) { const int st = (r >> 4) * 2 + (c >> 5), rr = r & 15, cc = c & 31, ob = rr * 64 + cc * 2; return st * 1024 + (ob ^ (((ob >> 9) & 1) << 5)); }
__host__ __device__ __forceinline__ void stage_rc(int b, int& R, int& C) { const int st = b / 1024, sb = b % 1024, swz = sb ^ (((sb >> 9) & 1) << 5); R = (st >> 1) * 16 + swz / 64; C = (st & 1) * 32 + (swz % 64) / 2; }
__host__ __device__ __forceinline__ int perm32(int rho) { const int n = rho >> 4, i = rho & 15; return 8 * (i >> 2) + 4 * n + (i & 3); }

struct Unit { int pm, pn; };
struct Gemm { const bf16_t* A; const bf16_t* Bt; int M, N, K; };

struct StaticOrder {
    int nM, nN, nwg, G, c;
    __host__ __device__ void init(int M, int N, int G_, int c_) { nM = M / BM; nN = N / BM; nwg = nM * nN; G = G_; c = c_; }
    __host__ __device__ bool next(int i, Unit& u) const {
        const long L = (long)i * G + c; if (L >= nwg) return false;
        int wgid = (int)L; { const int q = nwg / NXCD, r = nwg % NXCD, xcd = wgid % NXCD, off = wgid / NXCD; wgid = (xcd < r ? xcd * (q + 1) : r * (q + 1) + (xcd - r) * q) + off; }
        const int nig = WGM * nN, gid = wgid / nig, fm = gid * WGM, gsz = (nM - fm) < WGM ? (nM - fm) : WGM;
        u.pm = fm + ((wgid % nig) % gsz); u.pn = (wgid % nig) / gsz; return true;
    }
    __device__ __forceinline__ void a_ready(const Unit&) const {}
    __device__ __forceinline__ void done(const Unit&) const {}
};
typedef __bf16 bf16x2_t __attribute__((ext_vector_type(2)));
typedef float f32x2_t __attribute__((ext_vector_type(2)));
__device__ __forceinline__ unsigned cvt_pk_bf16(float lo, float hi) { const f32x2_t v = {lo, hi}; const bf16x2_t b = __builtin_convertvector(v, bf16x2_t); return __builtin_bit_cast(unsigned, b); }
constexpr float RMS_EPS = 1e-6f;
constexpr int DM = 2048, DFF = 5504, INW = 12800;
typedef unsigned long long ss_t;
__device__ __forceinline__ ss_t ss_fix(float ss) { return (ss_t)(ss * 4294967296.0f); }
__device__ __forceinline__ float rstd_of(ss_t ss) { return __builtin_amdgcn_rsqf((float)ss * (1.0f / 4294967296.0f / 2048.0f) + RMS_EPS); }
__device__ __forceinline__ float sigmoid_f(float x) { return __builtin_amdgcn_rcpf(1.0f + __expf(-x)); }
__device__ __forceinline__ float silu_f(float x) { return x * sigmoid_f(x); }
typedef unsigned u32x2 __attribute__((ext_vector_type(2)));
__device__ __forceinline__ int lane_id_fresh() { int l; asm volatile("v_mbcnt_lo_u32_b32 %0, -1, 0\n\tv_mbcnt_hi_u32_b32 %0, -1, %0" : "=v"(l)); return l; }
__device__ __forceinline__ float ub0(unsigned w) { return (float)(w & 0xffu); }
__device__ __forceinline__ float ub1(unsigned w) { return (float)((w >> 8) & 0xffu); }
__device__ __forceinline__ float ub2(unsigned w) { return (float)((w >> 16) & 0xffu); }
__device__ __forceinline__ float ub3(unsigned w) { return (float)(w >> 24); }
__device__ __forceinline__ float bflo(unsigned w) { return __uint_as_float(w << 16); }
__device__ __forceinline__ float bfhi(unsigned w) { return __uint_as_float(w & 0xffff0000u); }

struct EpiFfnUp {
    static constexpr bool PERM = true, AFTER_DRAIN = false;
    struct State { ss_t rs[8]; };
    bf16_t* H; const ss_t* rowss;
    __device__ __forceinline__ void init(f32x4 (&acc)[2][2][4][2], State& st, const Unit& u, int wr, int wc, int fr, int fq) const {
#pragma unroll
        for (int ai = 0; ai < 2; ++ai)
#pragma unroll
            for (int m = 0; m < 4; ++m) st.rs[ai * 4 + m] = rowss[u.pm * BM + wr * 64 + fr + ai * HALF + m * 16];
#pragma unroll
        for (int a = 0; a < 2; ++a)
#pragma unroll
            for (int b = 0; b < 2; ++b)
#pragma unroll
                for (int m = 0; m < 4; ++m)
#pragma unroll
                    for (int n = 0; n < 2; ++n) acc[a][b][m][n] = (f32x4){0.f, 0.f, 0.f, 0.f};
    }
    __device__ __forceinline__ void operator()(const f32x4 (&acc)[2][2][4][2], const State& st, const Unit& u, int wr, int wc, int fr, int fq) const {
        const int row0 = u.pm * BM + wr * 64 + fr, col0 = u.pn * 128 + wc * 32 + 8 * fq;
#pragma unroll
        for (int ai = 0; ai < 2; ++ai)
#pragma unroll
            for (int m = 0; m < 4; ++m) {
                const int row = row0 + ai * HALF + m * 16; const float rs = rstd_of(st.rs[ai * 4 + m]);
                float h[8];
#pragma unroll
                for (int n = 0; n < 2; ++n)
#pragma unroll
                    for (int j = 0; j < 4; ++j) { const float g = rs * acc[ai][0][m][n][j], up = rs * acc[ai][1][m][n][j]; h[4 * n + j] = silu_f(g) * up; }
                u32x4 w; w.x = cvt_pk_bf16(h[0], h[1]); w.y = cvt_pk_bf16(h[2], h[3]); w.z = cvt_pk_bf16(h[4], h[5]); w.w = cvt_pk_bf16(h[6], h[7]);
                *(u32x4*)(H + (size_t)row * DFF + col0) = w;
            }
    }
};
struct EpiResid {
    static constexpr bool PERM = true, AFTER_DRAIN = false;
    struct State {};
    bf16_t* XB; ss_t* rowss_out; float scale, inv_scale;
    __device__ __forceinline__ void init(f32x4 (&acc)[2][2][4][2], State&, const Unit& u, int wr, int wc, int fr, int fq) const {
        const int row0 = u.pm * BM + wr * 64 + fr, col0 = u.pn * BM + wc * 32 + 8 * fq;
#pragma unroll
        for (int ai = 0; ai < 2; ++ai)
#pragma unroll
            for (int m = 0; m < 4; ++m)
#pragma unroll
                for (int bj = 0; bj < 2; ++bj) {
                    const u32x4 xw = *(const u32x4*)(XB + (size_t)(row0 + ai * HALF + m * 16) * DM + col0 + bj * HALF);
                    acc[ai][bj][m][0] = (f32x4){bflo(xw.x), bfhi(xw.x), bflo(xw.y), bfhi(xw.y)} * inv_scale; acc[ai][bj][m][1] = (f32x4){bflo(xw.z), bfhi(xw.z), bflo(xw.w), bfhi(xw.w)} * inv_scale;
                }
    }
    __device__ __forceinline__ void operator()(const f32x4 (&acc)[2][2][4][2], const State& st, const Unit& u, int wr, int wc, int fr, int fq) const {
        const int row0 = u.pm * BM + wr * 64 + fr, col0 = u.pn * BM + wc * 32 + 8 * fq;
#pragma unroll
        for (int ai = 0; ai < 2; ++ai)
#pragma unroll
            for (int m = 0; m < 4; ++m) {
                const int row = row0 + ai * HALF + m * 16; float ss = 0.f;
#pragma unroll
                for (int bj = 0; bj < 2; ++bj) {
                    const f32x4 x0 = acc[ai][bj][m][0] * scale, x1 = acc[ai][bj][m][1] * scale;
                    u32x4 w; w.x = cvt_pk_bf16(x0[0], x0[1]); w.y = cvt_pk_bf16(x0[2], x0[3]); w.z = cvt_pk_bf16(x1[0], x1[1]); w.w = cvt_pk_bf16(x1[2], x1[3]);
                    *(u32x4*)(XB + (size_t)row * DM + col0 + bj * HALF) = w;
                    ss += (x0[0] * x0[0] + x0[1] * x0[1]) + (x0[2] * x0[2] + x0[3] * x0[3]) + (x1[0] * x1[0] + x1[1] * x1[1]) + (x1[2] * x1[2] + x1[3] * x1[3]);
                }
                ss += __shfl_xor(ss, 16); ss += __shfl_xor(ss, 32);
                if (fq == 0) __hip_atomic_fetch_add(rowss_out + row, ss_fix(ss), __ATOMIC_RELAXED, __HIP_MEMORY_SCOPE_AGENT);
            }
    }
};
constexpr float QSCALE = 0.08838834764831845f * 1.4426950408889634f;
constexpr int ZC_QA = 0, ZC_KA = 1536, ZC_VA = 3072, ZC_QH = 4608, ZC_FH = 5632, ZC_IH = 6656, ZC_GH = 7680, ZC_GA = 8704, ZC_GM = 10752;
constexpr int M_ROWS = 16384, SEQ_LEN = 2048;
constexpr size_t QKV_PART = (size_t)M_ROWS * 1536, HB_PART = (size_t)M_ROWS * 1024;
struct EpiZ {
    static constexpr bool PERM = true, AFTER_DRAIN = false;
    struct State { ss_t rs[8]; };
    bf16_t* QKV; bf16_t* HB; unsigned char* GATES; float* LOGF; const ss_t* rowss; const float* lb; const float* bgate;
    __device__ __forceinline__ void init(f32x4 (&acc)[2][2][4][2], State& st, const Unit& u, int wr, int wc, int fr, int fq) const {
#pragma unroll
        for (int ai = 0; ai < 2; ++ai)
#pragma unroll
            for (int m = 0; m < 4; ++m) st.rs[ai * 4 + m] = rowss[u.pm * BM + wr * 64 + fr + ai * HALF + m * 16];
#pragma unroll
        for (int a = 0; a < 2; ++a)
#pragma unroll
            for (int b = 0; b < 2; ++b)
#pragma unroll
                for (int m = 0; m < 4; ++m)
#pragma unroll
                    for (int n = 0; n < 2; ++n) acc[a][b][m][n] = (f32x4){0.f, 0.f, 0.f, 0.f};
    }
    __device__ __forceinline__ void operator()(const f32x4 (&acc)[2][2][4][2], const State& st, const Unit& u, int wr, int wc, int fr, int fq) const {
        const int pn = u.pn;
        const int mode = pn < 6 ? 0 : pn < 18 ? 1 : pn < 22 ? 2 : pn < 26 ? 3 : pn < 30 ? 1 : pn < 34 ? 2 : 4;
        const int region = pn < 18 ? 0 : pn < 34 ? 1 : 2;
        const int row0 = u.pm * BM + wr * 64 + fr, colb = pn * BM + wc * 32 + 8 * fq;
#pragma unroll
        for (int bj = 0; bj < 2; ++bj) {
            float par[8];
            {
                f32x4 p0 = (f32x4){0.f, 0.f, 0.f, 0.f}, p1 = p0;
                if (mode == 3) { const float* p = lb + (colb + bj * HALF - ZC_FH); p0 = *(const f32x4*)p; p1 = *(const f32x4*)(p + 4); }
                if (mode == 4) { const float* p = bgate + (colb + bj * HALF - ZC_GA); p0 = *(const f32x4*)p; p1 = *(const f32x4*)(p + 4); }
#pragma unroll
                for (int j = 0; j < 4; ++j) { par[j] = p0[j]; par[4 + j] = p1[j]; }
            }
            const int c0 = colb + bj * HALF;
#pragma unroll
            for (int ai = 0; ai < 2; ++ai)
#pragma unroll
                for (int m = 0; m < 4; ++m) {
                    const int row = row0 + ai * HALF + m * 16; const float rs = rstd_of(st.rs[ai * 4 + m]);
                    const int b = row >> 11, t = row & (SEQ_LEN - 1);
                    float v[8];
#pragma unroll
                    for (int n = 0; n < 2; ++n)
#pragma unroll
                        for (int j = 0; j < 4; ++j) v[4 * n + j] = rs * acc[ai][bj][m][n][j];
                    bf16_t* dst;
                    if (region == 0) {
                        const int part = c0 / 1536, cip = c0 - part * 1536, g = cip >> 9, hh = (cip >> 7) & 3, d = cip & 127, sh = 2 * g;
                        const int pt = ((t & ((1 << sh) - 1)) << (11 - sh)) + (t >> sh);
                        dst = QKV + (size_t)part * QKV_PART + ((size_t)(((b * 3 + g) * 4 + hh) * SEQ_LEN + pt) * 128 + d);
                    } else if (region == 1) {
                        const int hp = (c0 - ZC_QH) >> 10, cip = (c0 - ZC_QH) & 1023, hh = cip >> 7, k = cip & 127;
                        const size_t off = (size_t)((b * 8 + hh) * SEQ_LEN + t) * 128 + k;
                        dst = HB + (size_t)hp * HB_PART + off;
                        if (mode == 3) {
                            float lg[8];
#pragma unroll
                            for (int j = 0; j < 8; ++j) { const float l = par[j], fl = v[j]; const float sg = sigmoid_f(fl); lg[j] = __builtin_amdgcn_logf(l + (1.0f - l) * sg); v[j] = (1.0f - l) * __builtin_amdgcn_rcpf(1.0f + __expf(fl)); }
                            float* lp = LOGF + off;
                            *(f32x4*)lp = (f32x4){lg[0], lg[1], lg[2], lg[3]}; *(f32x4*)(lp + 4) = (f32x4){lg[4], lg[5], lg[6], lg[7]};
                        }
                    } else {
                        unsigned q[8];
#pragma unroll
                        for (int j = 0; j < 8; ++j) q[j] = (unsigned)(sigmoid_f(v[j] + par[j]) * 255.0f + 0.5f);
                        u32x2 gw8; gw8.x = q[0] | (q[1] << 8) | (q[2] << 16) | (q[3] << 24); gw8.y = q[4] | (q[5] << 8) | (q[6] << 16) | (q[7] << 24);
                        *(u32x2*)(GATES + (size_t)row * 4096 + (c0 - ZC_GA)) = gw8;
                        continue;
                    }
                    if (mode == 0) {
#pragma unroll
                        for (int j = 0; j < 8; ++j) v[j] *= QSCALE;
                    } else if (mode == 2) {
#pragma unroll
                        for (int j = 0; j < 8; ++j) v[j] = silu_f(v[j]);
                    }
                    u32x4 w; w.x = cvt_pk_bf16(v[0], v[1]); w.y = cvt_pk_bf16(v[2], v[3]); w.z = cvt_pk_bf16(v[4], v[5]); w.w = cvt_pk_bf16(v[6], v[7]);
                    *(u32x4*)dst = w;
                }
        }
    }
};
struct EpiPa {
    static constexpr bool PERM = true, AFTER_DRAIN = false;
    struct State {};
    const unsigned char* GATES; bf16_t* YA;
    __device__ __forceinline__ void init(f32x4 (&acc)[2][2][4][2], State&, const Unit&, int, int, int, int) const {
#pragma unroll
        for (int a = 0; a < 2; ++a)
#pragma unroll
            for (int b = 0; b < 2; ++b)
#pragma unroll
                for (int m = 0; m < 4; ++m)
#pragma unroll
                    for (int n = 0; n < 2; ++n) acc[a][b][m][n] = (f32x4){0.f, 0.f, 0.f, 0.f};
    }
    __device__ __forceinline__ void operator()(const f32x4 (&acc)[2][2][4][2], const State& st, const Unit& u, int wr, int wc, int fr, int fq) const {
        const int row0 = u.pm * BM + wr * 64 + fr, col0 = u.pn * BM + wc * 32 + 8 * fq;
        u32x2 g[2][4][2];
#pragma unroll
        for (int ai = 0; ai < 2; ++ai)
#pragma unroll
            for (int m = 0; m < 4; ++m)
#pragma unroll
                for (int bj = 0; bj < 2; ++bj) g[ai][m][bj] = *(const u32x2*)(GATES + (size_t)(row0 + ai * HALF + m * 16) * 4096 + col0 + bj * HALF);
#pragma unroll
        for (int ai = 0; ai < 2; ++ai)
#pragma unroll
            for (int m = 0; m < 4; ++m)
#pragma unroll
                for (int bj = 0; bj < 2; ++bj) {
                    const u32x2 gg = g[ai][m][bj]; const f32x4 a0 = acc[ai][bj][m][0] * (1.0f / 255.0f), a1 = acc[ai][bj][m][1] * (1.0f / 255.0f);
                    u32x4 w; w.x = cvt_pk_bf16(ub0(gg.x) * a0[0], ub1(gg.x) * a0[1]); w.y = cvt_pk_bf16(ub2(gg.x) * a0[2], ub3(gg.x) * a0[3]);
                    w.z = cvt_pk_bf16(ub0(gg.y) * a1[0], ub1(gg.y) * a1[1]); w.w = cvt_pk_bf16(ub2(gg.y) * a1[2], ub3(gg.y) * a1[3]);
                    *(u32x4*)(YA + (size_t)(row0 + ai * HALF + m * 16) * DM + col0 + bj * HALF) = w;
                }
    }
};
struct EpiPm {
    static constexpr bool PERM = true, AFTER_DRAIN = false;
    struct State {};
    const unsigned char* GATES; const bf16_t* YA; bf16_t* YB;
    __device__ __forceinline__ void init(f32x4 (&acc)[2][2][4][2], State&, const Unit&, int, int, int, int) const {
#pragma unroll
        for (int a = 0; a < 2; ++a)
#pragma unroll
            for (int b = 0; b < 2; ++b)
#pragma unroll
                for (int m = 0; m < 4; ++m)
#pragma unroll
                    for (int n = 0; n < 2; ++n) acc[a][b][m][n] = (f32x4){0.f, 0.f, 0.f, 0.f};
    }
    __device__ __forceinline__ void operator()(const f32x4 (&acc)[2][2][4][2], const State& st, const Unit& u, int wr, int wc, int fr, int fq) const {
        const int row0 = u.pm * BM + wr * 64 + fr, col0 = u.pn * BM + wc * 32 + 8 * fq;
#pragma unroll
        for (int ai = 0; ai < 2; ++ai) {
            u32x2 g[4][2]; u32x4 y[4][2];
#pragma unroll
            for (int m = 0; m < 4; ++m)
#pragma unroll
                for (int bj = 0; bj < 2; ++bj) {
                    g[m][bj] = *(const u32x2*)(GATES + (size_t)(row0 + ai * HALF + m * 16) * 4096 + 2048 + col0 + bj * HALF);
                    y[m][bj] = *(const u32x4*)(YA + (size_t)(row0 + ai * HALF + m * 16) * DM + col0 + bj * HALF);
                }
#pragma unroll
            for (int m = 0; m < 4; ++m)
#pragma unroll
                for (int bj = 0; bj < 2; ++bj) {
                    const u32x2 gg = g[m][bj]; const u32x4 yy = y[m][bj]; const f32x4 a0 = acc[ai][bj][m][0] * (1.0f / 255.0f), a1 = acc[ai][bj][m][1] * (1.0f / 255.0f);
                    u32x4 w;
                    w.x = cvt_pk_bf16(bflo(yy.x) + ub0(gg.x) * a0[0], bfhi(yy.x) + ub1(gg.x) * a0[1]); w.y = cvt_pk_bf16(bflo(yy.y) + ub2(gg.x) * a0[2], bfhi(yy.y) + ub3(gg.x) * a0[3]);
                    w.z = cvt_pk_bf16(bflo(yy.z) + ub0(gg.y) * a1[0], bfhi(yy.z) + ub1(gg.y) * a1[1]); w.w = cvt_pk_bf16(bflo(yy.w) + ub2(gg.y) * a1[2], bfhi(yy.w) + ub3(gg.y) * a1[3]);
                    *(u32x4*)(YB + (size_t)(row0 + ai * HALF + m * 16) * DM + col0 + bj * HALF) = w;
                }
        }
    }
};
template <class Epi, class Sched, bool ALIGN_EPI = false, bool SP2 = false>
__device__ __forceinline__ void gemm_phase(PG8_LAS unsigned char* lds, const Gemm g, const Sched& S, const Epi& E, int wave_id) {
    int wid_l = wave_id; asm volatile("" : "+s"(wid_l));
    const int lane = lane_id_fresh(), wid = wid_l, tid = wid * 64 + lane, wr = wid >> 2, wc = wid & 3, fr = lane & 15, fq = lane >> 4;
    const int K = g.K, nt = K / BK;
    unsigned voffA[2], voffB[2];
#pragma unroll
    for (int i = 0; i < 2; ++i) { int R, C; stage_rc(tid * 16 + i * 8192, R, C); const int Rb = Epi::PERM ? ((R & ~31) + perm32(R & 31)) : R;
        voffA[i] = (unsigned)(R * K + C) * 2u; voffB[i] = (unsigned)(Rb * K + C) * 2u; }
    const size_t kstep = (size_t)(BK * 2);
    const size_t hstep = (size_t)HALF * K * 2;
    const size_t tstep = 2 * hstep;
    const unsigned ldsw = (unsigned)wid * 1024u;
    const int aoff = lds_byte(wr * 64 + fr, fq * 8), boff = lds_byte(wc * 32 + fr, fq * 8);
#define PG8_SA(b, h) (((b) * 2 + (h)) * HTB)
#define PG8_SB(b, h) ((4 + (b) * 2 + (h)) * HTB)
#define PG8_STAGE(bufoff, gbase, voff) do { _Pragma("unroll") for (int _i = 0; _i < 2; ++_i) \
        __builtin_amdgcn_global_load_lds((const unsigned*)((const char*)(gbase) + (voff)[_i]), (PG8_LAS unsigned*)(lds + (bufoff) + ldsw + _i * 8192), 16, 0, 0); } while (0)
#define PG8_LDA(dst, b, h) do { _Pragma("unroll") for (int m = 0; m < 4; ++m) _Pragma("unroll") for (int k = 0; k < 2; ++k) dst[m][k] = *(const PG8_LAS bf16x8*)(lds + PG8_SA(b, h) + aoff + m * 2048 + k * 1024); } while (0)
#define PG8_LDB(dst, b, h) do { _Pragma("unroll") for (int n = 0; n < 2; ++n) _Pragma("unroll") for (int k = 0; k < 2; ++k) dst[n][k] = *(const PG8_LAS bf16x8*)(lds + PG8_SB(b, h) + boff + n * 2048 + k * 1024); } while (0)
#define PG8_MMA(ai, bj, At, Bt) do { __builtin_amdgcn_s_setprio(1); _Pragma("unroll") for (int m = 0; m < 4; ++m) _Pragma("unroll") for (int n = 0; n < 2; ++n) _Pragma("unroll") for (int k = 0; k < 2; ++k) \
        acc[ai][bj][m][n] = __builtin_amdgcn_mfma_f32_16x16x32_bf16(Bt[n][k], At[m][k], acc[ai][bj][m][n], 0, 0, 0); __builtin_amdgcn_s_setprio(0); } while (0)
#define PG8_WAIT_V(n) asm volatile("s_waitcnt vmcnt(" #n ")" ::: "memory")
#define PG8_WAIT_L(n) asm volatile("s_waitcnt lgkmcnt(" #n ")" ::: "memory")
#define PG8_BAR __builtin_amdgcn_s_barrier()
#define PG8_SCHED __builtin_amdgcn_sched_barrier(0)
    Unit cur, nxt; int ui = 0;
    if (!S.next(0, cur)) return;
    f32x4 acc[2][2][4][2]; typename Epi::State est;
    E.init(acc, est, cur, wr, wc, fr, fq);
    bf16x8 At[4][2], B0[2][2], B1[2][2];
    const char* cA = (const char*)g.A + (size_t)cur.pm * tstep; const char* cB = (const char*)g.Bt + (size_t)cur.pn * tstep;
    S.a_ready(cur);
    if constexpr (SP2) {
        PG8_STAGE(PG8_SB(0, 0), cB, voffB); PG8_STAGE(PG8_SB(0, 1), cB + hstep, voffB); PG8_STAGE(PG8_SA(0, 0), cA, voffA); PG8_STAGE(PG8_SA(0, 1), cA + hstep, voffA);
        if (wr == 1) PG8_BAR;
        PG8_WAIT_V(2); PG8_BAR;
        PG8_STAGE(PG8_SB(1, 0), cB + kstep, voffB); PG8_STAGE(PG8_SA(1, 0), cA + kstep, voffA); PG8_STAGE(PG8_SB(1, 1), cB + hstep + kstep, voffB);
        PG8_WAIT_V(6); PG8_BAR;
    } else {
        PG8_STAGE(PG8_SB(0, 0), cB, voffB); PG8_STAGE(PG8_SA(0, 0), cA, voffA); PG8_STAGE(PG8_SB(0, 1), cB + hstep, voffB); PG8_STAGE(PG8_SA(0, 1), cA + hstep, voffA);
        if (wr == 1) PG8_BAR;
        PG8_WAIT_V(4); PG8_BAR;
        PG8_STAGE(PG8_SB(1, 0), cB + kstep, voffB); PG8_STAGE(PG8_SA(1, 0), cA + kstep, voffA); PG8_STAGE(PG8_SB(1, 1), cB + hstep + kstep, voffB);
        PG8_WAIT_V(6); PG8_BAR;
    }
    for (;;) {
        const bool has_next = S.next(ui + 1, nxt);
        const char* nA = has_next ? (const char*)g.A + (size_t)nxt.pm * tstep : cA; const char* nB = has_next ? (const char*)g.Bt + (size_t)nxt.pn * tstep : cB;
        for (int t = 0; t < nt; t += 2) {
            const bool last = (t == nt - 2);
            const char* a1 = cA + (size_t)(t + 1) * kstep;
            const char* a2 = last ? nA : cA + (size_t)(t + 2) * kstep; const char* b2 = last ? nB : cB + (size_t)(t + 2) * kstep;
            const char* a3 = a2 + kstep; const char* b3 = b2 + kstep;
            if (last && has_next) S.a_ready(nxt);
            if constexpr (SP2) {
            PG8_LDB(B0, 0, 0); PG8_LDB(B1, 0, 1); PG8_SCHED; PG8_LDA(At, 0, 0); PG8_STAGE(PG8_SA(1, 1), a1 + hstep, voffA);
            PG8_WAIT_V(8); PG8_WAIT_L(0); PG8_BAR; PG8_MMA(0, 0, At, B0); PG8_MMA(0, 1, At, B1); PG8_BAR; PG8_SCHED;
            PG8_LDA(At, 0, 1); PG8_STAGE(PG8_SB(0, 0), b2, voffB); PG8_STAGE(PG8_SB(0, 1), b2 + hstep, voffB); PG8_STAGE(PG8_SA(0, 0), a2, voffA);
            PG8_WAIT_V(8); PG8_WAIT_L(0); PG8_BAR; PG8_MMA(1, 0, At, B0); PG8_MMA(1, 1, At, B1); PG8_BAR; PG8_SCHED;
            PG8_LDB(B0, 1, 0); PG8_LDB(B1, 1, 1); PG8_SCHED; PG8_LDA(At, 1, 0); PG8_STAGE(PG8_SA(0, 1), a2 + hstep, voffA);
            PG8_WAIT_V(8); PG8_WAIT_L(0); PG8_BAR; PG8_MMA(0, 0, At, B0); PG8_MMA(0, 1, At, B1); PG8_BAR; PG8_SCHED;
            PG8_LDA(At, 1, 1); PG8_STAGE(PG8_SB(1, 0), b3, voffB); PG8_STAGE(PG8_SB(1, 1), b3 + hstep, voffB); PG8_STAGE(PG8_SA(1, 0), a3, voffA);
            PG8_WAIT_V(8); PG8_WAIT_L(0); PG8_BAR; PG8_MMA(1, 0, At, B0); PG8_MMA(1, 1, At, B1); PG8_BAR; PG8_SCHED;
            } else {
            PG8_LDB(B0, 0, 0); PG8_SCHED; PG8_LDA(At, 0, 0); PG8_STAGE(PG8_SA(1, 1), a1 + hstep, voffA);
            PG8_WAIT_L(8); PG8_BAR; PG8_WAIT_L(0); PG8_MMA(0, 0, At, B0); PG8_BAR; PG8_SCHED;
            PG8_LDB(B1, 0, 1); PG8_STAGE(PG8_SB(0, 0), b2, voffB);
            PG8_BAR; PG8_WAIT_L(0); PG8_MMA(0, 1, At, B1); PG8_BAR;
            PG8_LDA(At, 0, 1); PG8_STAGE(PG8_SA(0, 0), a2, voffA);
            PG8_BAR; PG8_WAIT_L(0); PG8_MMA(1, 0, At, B0); PG8_BAR; PG8_SCHED;
            PG8_STAGE(PG8_SB(0, 1), b2 + hstep, voffB);
            PG8_WAIT_V(6); PG8_BAR; PG8_MMA(1, 1, At, B1); PG8_BAR;
            PG8_LDB(B0, 1, 0); PG8_SCHED; PG8_LDA(At, 1, 0); PG8_STAGE(PG8_SA(0, 1), a2 + hstep, voffA);
            PG8_WAIT_L(8); PG8_BAR; PG8_WAIT_L(0); PG8_MMA(0, 0, At, B0); PG8_BAR; PG8_SCHED;
            PG8_LDB(B1, 1, 1); PG8_STAGE(PG8_SB(1, 0), b3, voffB);
            PG8_BAR; PG8_WAIT_L(0); PG8_MMA(0, 1, At, B1); PG8_BAR;
            PG8_LDA(At, 1, 1); PG8_STAGE(PG8_SA(1, 0), a3, voffA);
            PG8_BAR; PG8_WAIT_L(0); PG8_MMA(1, 0, At, B0); PG8_BAR; PG8_SCHED;
            PG8_STAGE(PG8_SB(1, 1), b3 + hstep, voffB);
            PG8_WAIT_V(6); PG8_BAR; PG8_MMA(1, 1, At, B1); PG8_BAR;
            }
        }
        if constexpr (ALIGN_EPI) { if (wr == 0) PG8_BAR; }
        if constexpr (!Epi::AFTER_DRAIN) { E(acc, est, cur, wr, wc, fr, fq); S.done(cur); }
        if (!has_next) break;
        E.init(acc, est, nxt, wr, wc, fr, fq);
        cur = nxt; cA = nA; cB = nB; ++ui;
        if constexpr (ALIGN_EPI) { if (wr == 1) PG8_BAR; }
    }
    PG8_WAIT_V(0);
    if constexpr (!ALIGN_EPI) { if (wr == 0) PG8_BAR; }
    PG8_BAR;
    if constexpr (Epi::AFTER_DRAIN) { E.fused(acc, cur, wr, wc, fr, fq, lds, wid, lane); S.done(cur); }
#undef PG8_SA
#undef PG8_SB
#undef PG8_STAGE
#undef PG8_LDA
#undef PG8_LDB
#undef PG8_MMA
#undef PG8_WAIT_V
#undef PG8_WAIT_L
#undef PG8_BAR
#undef PG8_SCHED
}
}
#define GAS __attribute__((address_space(1)))
#define LAS __attribute__((address_space(3)))
typedef unsigned short bf16;
typedef unsigned v4u __attribute__((ext_vector_type(4)));
typedef float f32x4 __attribute__((ext_vector_type(4)));
typedef short bf16x8 __attribute__((ext_vector_type(8)));
typedef GAS unsigned gu32;
typedef GAS unsigned long long gu64;
#define RLX_AGENT __ATOMIC_RELAXED, __HIP_MEMORY_SCOPE_AGENT
#define LDS_WAIT() asm volatile("s_waitcnt lgkmcnt(0)" ::: "memory")
#define VM_WAIT() asm volatile("s_waitcnt vmcnt(0)" ::: "memory")
__device__ __forceinline__ unsigned long long rt() { return __builtin_amdgcn_s_memrealtime(); }
__device__ __forceinline__ unsigned f2bf(float f) { unsigned u = __builtin_bit_cast(unsigned, f); return (u + 0x7fffu + ((u >> 16) & 1u)) >> 16; }
__device__ __forceinline__ unsigned pk2(float lo, float hi) { return pg8::cvt_pk_bf16(lo, hi); }

#define XB_TMO      128
#define XB_XCNT(j)  (256  + 64 * (j))
#define XB_XSUB(j)  (1280 + 64 * (j))
#define XB_XGEN(j)  (2304 + 64 * (j))
#define XB_TOP      3328
#define XB_TOPGEN   3392
#define XCD_BAR_WORDS 3456
#define XB_SPIN_CAP (1u << 18)

__device__ __forceinline__ unsigned xb_ld(unsigned* p)              { return __hip_atomic_load(p, __ATOMIC_RELAXED, __HIP_MEMORY_SCOPE_AGENT); }
__device__ __forceinline__ unsigned xb_add(unsigned* p, unsigned v) { return __hip_atomic_fetch_add(p, v, __ATOMIC_RELAXED, __HIP_MEMORY_SCOPE_AGENT); }
__device__ __forceinline__ unsigned xb_xcc_id() { return (unsigned)__builtin_amdgcn_s_getreg((3 << 11) | 20) & 0xFu; }
#define XB_SPIN(cond, bar) do { unsigned _sp = 0; while (cond) { __builtin_amdgcn_s_sleep(1); \
    if ((++_sp & 255u) == 0u) { if (xb_ld(&(bar)[XB_TMO])) break; if (_sp > XB_SPIN_CAP) { atomicAdd(&(bar)[XB_TMO], 1u); break; } } } } while (0)

struct XcdBarrier {
    unsigned* bar; unsigned x;
    int w;
    volatile LAS unsigned* st;
};

__device__ __forceinline__ XcdBarrier xcd_barrier_post(unsigned* bar, volatile LAS unsigned* st) {
    XcdBarrier b; b.bar = bar; b.x = xb_xcc_id(); b.st = st; b.w = __builtin_amdgcn_readfirstlane((int)threadIdx.x >> 6);
    if (threadIdx.x == 0) (void)xb_add(&bar[XB_XCNT(b.x)], 1u);
    return b;
}
__device__ __forceinline__ void xcd_barrier_complete(unsigned* bar, unsigned x, unsigned& nloc, unsigned& nx) {
    const unsigned G = gridDim.x * gridDim.y * gridDim.z;
    unsigned sum, cnt, mine, sp = 0u;
    for (;;) {
        sum = 0u; cnt = 0u; mine = 0u;
#pragma unroll
        for (unsigned j = 0; j < 16; ++j) { const unsigned c = xb_ld(&bar[XB_XCNT(j)]); sum += c; cnt += (c > 0u) ? 1u : 0u; mine = (j == x) ? c : mine; }
        if (sum == G) break;
        __builtin_amdgcn_s_sleep(1);
        if ((++sp & 255u) == 0u) { if (xb_ld(&bar[XB_TMO])) break; if (sp > XB_SPIN_CAP) { atomicAdd(&bar[XB_TMO], 1u); break; } }
    }
    nloc = mine > 0u ? mine : 1u; nx = cnt > 0u ? cnt : 1u;
}

__device__ __forceinline__ void xcd_barrier(const XcdBarrier& b) {
    asm volatile("s_waitcnt vmcnt(0)" ::: "memory");
    __syncthreads();
    if (b.w == 0 && pg8::lane_id_fresh() == 0) {
        unsigned* bar = b.bar;
        __builtin_amdgcn_s_waitcnt(0);
        unsigned nloc = b.st[0], nx = b.st[1];
        if (nloc == 0u) { xcd_barrier_complete(bar, b.x, nloc, nx); b.st[0] = nloc; b.st[1] = nx; }
        const unsigned old = xb_add(&bar[XB_XSUB(b.x)], 1u);
        const unsigned gen = old / nloc;
        if (old + 1u == (gen + 1u) * nloc) {
            __builtin_amdgcn_fence(__ATOMIC_RELEASE, "agent");
            asm volatile("s_waitcnt vmcnt(0)" ::: "memory");
            const unsigned og = xb_add(&bar[XB_TOP], 1u);
            const unsigned tg = og / nx;
            if (og + 1u == (tg + 1u) * nx) xb_add(&bar[XB_TOPGEN], 1u);
            else XB_SPIN(xb_ld(&bar[XB_TOPGEN]) == tg, bar);
            __builtin_amdgcn_fence(__ATOMIC_ACQUIRE, "agent");
            xb_add(&bar[XB_XGEN(b.x)], 1u);
            asm volatile("s_waitcnt vmcnt(0)" ::: "memory");
        } else {
            XB_SPIN(xb_ld(&bar[XB_XGEN(b.x)]) == gen, bar);
            __builtin_amdgcn_fence(__ATOMIC_ACQUIRE, "agent");
            asm volatile("s_waitcnt vmcnt(0)" ::: "memory");
        }
    }
    __syncthreads();
}

constexpr int NWAVES = 8;
constexpr int BATCH = 8, SEQ = 2048, M = BATCH * SEQ, DEPTH = 4;
constexpr int DM = pg8::DM, DFF = pg8::DFF, NUP = 2 * DFF, INW = pg8::INW;
constexpr int AW = 512, HW = 1024;
using pg8::ZC_QA; using pg8::ZC_KA; using pg8::ZC_VA; using pg8::ZC_QH; using pg8::ZC_FH; using pg8::ZC_IH; using pg8::ZC_GH;
constexpr float RMS_EPS = 1e-6f;
#ifndef MK_ONE_LAUNCH
#define MK_ONE_LAUNCH 1
#endif
constexpr int N_PHASES = 1 + 8 * 2 + 4 * 5 + 1;

constexpr size_t MiB = 1u << 20;
constexpr size_t WS_CTL = 0, CTL_ZERO_BYTES = 4 * MiB;
constexpr size_t WS_ROWSS = 2 * MiB;
constexpr size_t WS_LB = 4 * MiB;
constexpr size_t WS_X = 16 * MiB;
constexpr size_t WS_XB = 144 * MiB;
constexpr size_t WS_HFF = 208 * MiB;
constexpr size_t WS_Z = 384 * MiB;
constexpr size_t WS_LOGF = 784 * MiB;
constexpr size_t WS_ATT = 848 * MiB;
constexpr size_t WS_HG = 864 * MiB;
constexpr size_t WS_Y32 = 896 * MiB;
constexpr size_t WS_YB = 1024 * MiB;
constexpr size_t WS_O32 = 1088 * MiB;
constexpr size_t WS_AO = 1152 * MiB;
constexpr size_t WS_LSE = 1200 * MiB;
constexpr size_t WS_SLOC = 1216 * MiB;
constexpr size_t WS_DTOT = 1249 * MiB;
constexpr size_t WS_W = 1300 * MiB;
constexpr size_t WL_BYTES = 193 * MiB;
constexpr size_t WO_W1 = 0, W1_BYTES = 43 * MiB, WO_W2 = 86 * MiB, W2_BYTES = (size_t)DM * DFF * 2, WO_WIN = 129 * MiB, WO_WPA = 179 * MiB, WO_WPM = 181 * MiB, WO_WO = 185 * MiB;
constexpr size_t WS_END = WS_W + 4 * WL_BYTES;
static_assert((size_t)NUP * DM * 2 == W1_BYTES && 2 * W2_BYTES == 43 * MiB && (size_t)INW * DM * 2 == 50 * MiB, "weight map");
static_assert(WS_HFF + (size_t)M * DFF * 2 <= WS_Z && WS_Z + (size_t)M * INW * 2 <= WS_LOGF, "ws map");
constexpr int CW_BAR = 4096;

constexpr int RING_OFF = 0, RING_BYTES = 131072;
constexpr int LDS_BYTES = 159744;
constexpr int LDSCTL_OFF = LDS_BYTES - 512, MISC_OFF = LDSCTL_OFF + 320;
static_assert(MISC_OFF + 128 <= LDS_BYTES, "LDS map");

__device__ __forceinline__ float wave_sum(float v) {
#pragma unroll
    for (int o = 1; o < 64; o <<= 1) v += __shfl_xor(v, o);
    return v;
}
using pg8::bflo; using pg8::bfhi; using pg8::lane_id_fresh;
typedef float f32x2 __attribute__((ext_vector_type(2)));
using pg8::u32x2;

__device__ __forceinline__ void tr_item(const float* __restrict__ W, int K, int N, bf16* __restrict__ WT, const float* __restrict__ gain, bool ilv, LAS float* scr, int item, int lane) {
    const int nblk = N >> 5, kb = item / nblk, nb = item - kb * nblk, k0 = kb << 6, n0 = nb << 5;
    const int lr = lane >> 3, c4 = (lane & 7) << 2;
#pragma unroll
    for (int i = 0; i < 8; ++i) {
        const int kk = 8 * i + lr;
        const f32x4 v = *(const GAS f32x4*)(W + (size_t)(k0 + kk) * N + n0 + c4);
        const float g = gain ? gain[k0 + kk] : 1.0f;
        LAS float* d = scr + kk * 33 + c4;
        d[0] = v.x * g; d[1] = v.y * g; d[2] = v.z * g; d[3] = v.w * g;
    }
    LDS_WAIT(); asm volatile("" ::: "memory");
    const int c = lane & 7;
#pragma unroll
    for (int j = 0; j < 4; ++j) {
        const int n = (lane >> 3) + 8 * j; const LAS float* s = scr + (8 * c) * 33 + n;
        v4u o; o.x = pk2(s[0 * 33], s[1 * 33]); o.y = pk2(s[2 * 33], s[3 * 33]); o.z = pk2(s[4 * 33], s[5 * 33]); o.w = pk2(s[6 * 33], s[7 * 33]);
        const int col = n0 + n; int drow = col;
        if (ilv) { const int up = col >= DFF ? 1 : 0; const int jj = up ? col - DFF : col; drow = ((jj >> 7) << 8) + (up << 7) + (jj & 127); }
        *(GAS v4u*)(WT + (size_t)drow * K + k0 + 8 * c) = o;
    }
    LDS_WAIT(); asm volatile("" ::: "memory");
}

struct Args { const float* in[13]; float* out; unsigned char* ws; int ph_lo, ph_hi; };
constexpr int I_W1 = (DM / 64) * (NUP / 32), I_W2 = (DFF / 64) * (DM / 32), I_WIN = (DM / 64) * (INW / 32), I_WPA = (AW / 64) * (DM / 32), I_WPM = (HW / 64) * (DM / 32), I_WO = (DM / 64) * (DM / 32);
constexpr int I_LAYER = 2 * I_W1 + 2 * I_W2 + I_WIN + I_WPA + I_WPM + I_WO;
struct ConvSrc { const float *ffn_norm, *ffn_w_in, *ffn_w_out, *mix_norm, *w_in, *w_pa, *w_pm, *w_o; unsigned char* ws; };
__device__ __forceinline__ ConvSrc conv_src() {
    const __attribute__((address_space(4))) Args* ka = (const __attribute__((address_space(4))) Args*)__builtin_amdgcn_kernarg_segment_ptr();
    asm volatile("" : "+s"(ka));
    return ConvSrc{ka->in[1], ka->in[2], ka->in[3], ka->in[4], ka->in[5], ka->in[9], ka->in[10], ka->in[11], ka->ws};
}
__device__ __forceinline__ void conv_item(const ConvSrc& C, int it, LAS float* scr, int lane) {
    const int l = it / I_LAYER; int r = it - l * I_LAYER;
    unsigned char* wl = C.ws + WS_W + (size_t)l * WL_BYTES;
    if (r < 2 * I_W1) { const int s = r >= I_W1 ? 1 : 0; r -= s * I_W1;
        tr_item(C.ffn_w_in + (size_t)(l * 2 + s) * DM * NUP, DM, NUP, (bf16*)(wl + WO_W1 + s * W1_BYTES), C.ffn_norm + (size_t)(l * 2 + s) * DM, true, scr, r, lane); return; }
    r -= 2 * I_W1;
    if (r < 2 * I_W2) { const int s = r >= I_W2 ? 1 : 0; r -= s * I_W2;
        tr_item(C.ffn_w_out + (size_t)(l * 2 + s) * DFF * DM, DFF, DM, (bf16*)(wl + WO_W2 + s * W2_BYTES), nullptr, false, scr, r, lane); return; }
    r -= 2 * I_W2;
    if (r < I_WIN) { tr_item(C.w_in + (size_t)l * DM * INW, DM, INW, (bf16*)(wl + WO_WIN), C.mix_norm + (size_t)l * DM, false, scr, r, lane); return; }
    r -= I_WIN;
    if (r < I_WPA) { tr_item(C.w_pa + (size_t)l * AW * DM, AW, DM, (bf16*)(wl + WO_WPA), nullptr, false, scr, r, lane); return; }
    r -= I_WPA;
    if (r < I_WPM) { tr_item(C.w_pm + (size_t)l * HW * DM, HW, DM, (bf16*)(wl + WO_WPM), nullptr, false, scr, r, lane); return; }
    r -= I_WPM;
    tr_item(C.w_o + (size_t)l * DM * DM, DM, DM, (bf16*)(wl + WO_WO), nullptr, false, scr, r, lane);
}
constexpr int AT_KSTR = 272, AT_VSTR = 528, AT_K_OFF = 0, AT_V_OFF = 256 * AT_KSTR;
static_assert(AT_V_OFF + 128 * AT_VSTR <= LDSCTL_OFF, "attention LDS");
#define AT_BAR() do { asm volatile("s_waitcnt lgkmcnt(0)" ::: "memory"); __builtin_amdgcn_s_barrier(); asm volatile("" ::: "memory"); } while (0)
__device__ __forceinline__ void attn_fast(LAS unsigned char* lds, const bf16* __restrict__ QKV, bf16* __restrict__ AO, float* __restrict__ LSE, int bx, int G, int w) {
    const int lane = lane_id_fresh(), tid = w * 64 + lane, fr = lane & 15, fq = lane >> 4;
    for (int idx = bx; idx < 1536; idx += G) {
        const int g = idx >> 9, rem = idx & 511, b = rem >> 6, h = (rem >> 4) & 3, blk = rem & 15;
        const int sh = 2 * g, nb = 16 >> sh, c = blk >> (4 - sh), n = blk & (nb - 1);
        const int j0 = n > 0 ? 0 : 128;
        const size_t zb = (size_t)b * SEQ;
        const size_t sb = ((size_t)((b * 3 + g) * 4 + h) * SEQ + (size_t)c * (SEQ >> sh)) * 128;
        const bf16* QA = QKV + sb; const bf16* KA = QKV + pg8::QKV_PART + sb; const bf16* VA = QKV + 2 * pg8::QKV_PART + sb;
        const int qi = 16 * w + fr; const size_t qrow = zb + ((size_t)(128 * n + qi) << sh) + c;
        bf16x8 qf[4];
#pragma unroll
        for (int ks = 0; ks < 4; ++ks) qf[ks] = *(const GAS bf16x8*)(QA + (size_t)(128 * n + qi) * 128 + 32 * ks + 8 * fq);
        if (n == 0) {
#pragma unroll
            for (int it = 0; it < 4; ++it) { const int ch = tid + 512 * it, d = ch >> 4, cc = ch & 15; *(LAS v4u*)(lds + AT_V_OFF + d * AT_VSTR + cc * 16) = (v4u){0u, 0u, 0u, 0u}; }
        }
#pragma unroll
        for (int it = 0; it < 8; ++it) {
            const int ch = tid + 512 * it, j = ch >> 4, dc = ch & 15;
            if (j >= j0) {
                const size_t go = (size_t)(128 * (n - 1) + j) * 128 + 8 * dc;
                const v4u kw = *(const GAS v4u*)(KA + go);
                const v4u vw = *(const GAS v4u*)(VA + go);
                *(LAS v4u*)(lds + AT_K_OFF + j * AT_KSTR + dc * 16) = kw;
                LAS unsigned short* vt = (LAS unsigned short*)(lds + AT_V_OFF + (8 * dc) * AT_VSTR) + (j ^ (dc << 2));
                vt[0 * (AT_VSTR / 2)] = (unsigned short)(vw.x & 0xffffu); vt[1 * (AT_VSTR / 2)] = (unsigned short)(vw.x >> 16);
                vt[2 * (AT_VSTR / 2)] = (unsigned short)(vw.y & 0xffffu); vt[3 * (AT_VSTR / 2)] = (unsigned short)(vw.y >> 16);
                vt[4 * (AT_VSTR / 2)] = (unsigned short)(vw.z & 0xffffu); vt[5 * (AT_VSTR / 2)] = (unsigned short)(vw.z >> 16);
                vt[6 * (AT_VSTR / 2)] = (unsigned short)(vw.w & 0xffffu); vt[7 * (AT_VSTR / 2)] = (unsigned short)(vw.w >> 16);
            }
        }
        AT_BAR();
        const int tl0 = n > 0 ? 0 : 8 - w;
        f32x4 st[9];
#pragma unroll
        for (int tl = 0; tl < 9; ++tl) {
            st[tl] = (f32x4){0.f, 0.f, 0.f, 0.f};
            if (tl >= tl0) {
                const int kt = w + tl;
#pragma unroll
                for (int ks = 0; ks < 4; ++ks) { const bf16x8 a = *(const LAS bf16x8*)(lds + AT_K_OFF + (16 * kt + fr) * AT_KSTR + (32 * ks + 8 * fq) * 2); st[tl] = __builtin_amdgcn_mfma_f32_16x16x32_bf16(a, qf[ks], st[tl], 0, 0, 0); }
            }
        }
        float mx = -1e30f;
#pragma unroll
        for (int tl = 0; tl < 9; ++tl)
#pragma unroll
            for (int i = 0; i < 4; ++i) { const int dlt = 16 * tl + 4 * fq + i - fr; const bool valid = (dlt >= 0) && (dlt <= 128) && (tl >= tl0); const float sv = valid ? st[tl][i] : -1e30f; st[tl][i] = sv; mx = fmaxf(mx, sv); }
        mx = fmaxf(mx, __shfl_xor(mx, 16)); mx = fmaxf(mx, __shfl_xor(mx, 32));
        float l = 0.f;
#pragma unroll
        for (int tl = 0; tl < 9; ++tl)
#pragma unroll
            for (int i = 0; i < 4; ++i) { const float pv = __builtin_amdgcn_exp2f(st[tl][i] - mx); st[tl][i] = pv; l += pv; }
        l += __shfl_xor(l, 16); l += __shfl_xor(l, 32);
        f32x4 o[8];
#pragma unroll
        for (int dt = 0; dt < 8; ++dt) o[dt] = (f32x4){0.f, 0.f, 0.f, 0.f};
#pragma unroll
        for (int p = 0; p < 5; ++p) {
            if (2 * p + 1 >= tl0) {
                v4u pw; pw.x = pk2(st[2 * p][0], st[2 * p][1]); pw.y = pk2(st[2 * p][2], st[2 * p][3]);
                if (p < 4) { pw.z = pk2(st[(2 * p + 1) % 9][0], st[(2 * p + 1) % 9][1]); pw.w = pk2(st[(2 * p + 1) % 9][2], st[(2 * p + 1) % 9][3]); } else { pw.z = 0u; pw.w = 0u; }
                const bf16x8 pb = __builtin_bit_cast(bf16x8, pw);
                const int kta = w + 2 * p, ktb = (w + 2 * p + 1) < 15 ? (w + 2 * p + 1) : 15;
#pragma unroll
                for (int dt = 0; dt < 8; ++dt) {
                    const int d = 16 * dt + fr, swz = (2 * dt + (fr >> 3)) << 2;
                    const u32x2 lo = *(const LAS u32x2*)(lds + AT_V_OFF + d * AT_VSTR + 2 * ((16 * kta + 4 * fq) ^ swz));
                    const u32x2 hi = *(const LAS u32x2*)(lds + AT_V_OFF + d * AT_VSTR + 2 * ((16 * ktb + 4 * fq) ^ swz));
                    const bf16x8 va = __builtin_bit_cast(bf16x8, (v4u){lo.x, lo.y, hi.x, hi.y});
                    o[dt] = __builtin_amdgcn_mfma_f32_16x16x32_bf16(va, pb, o[dt], 0, 0, 0);
                }
            }
        }
        const float inv = 1.0f / l;
        bf16* orow = AO + ((size_t)g * M + qrow) * AW + h * 128 + 4 * fq;
#pragma unroll
        for (int dt = 0; dt < 8; ++dt) { u32x2 ov; ov.x = pk2(o[dt][0] * inv, o[dt][1] * inv); ov.y = pk2(o[dt][2] * inv, o[dt][3] * inv); *(GAS u32x2*)(orow + 16 * dt) = ov; }
        if (fq == 0) LSE[((size_t)g * M + qrow) * 4 + h] = mx + __builtin_amdgcn_logf(l);
        AT_BAR();
    }
}
__device__ __forceinline__ void attn_combine(const bf16* __restrict__ AO, const float* __restrict__ LSE, bf16* __restrict__ ATT, int gw, int NGW) {
    const int lane = lane_id_fresh();
    for (int idx = gw * 64 + lane; idx < M * 64; idx += NGW * 64) {
        const int row = idx >> 6, h = (idx >> 4) & 3, dc = idx & 15;
        const float l0 = LSE[(size_t)row * 4 + h], l1 = LSE[((size_t)M + row) * 4 + h], l2 = LSE[((size_t)2 * M + row) * 4 + h];
        const float mx = fmaxf(l0, fmaxf(l1, l2));
        float w0 = __builtin_amdgcn_exp2f(l0 - mx), w1 = __builtin_amdgcn_exp2f(l1 - mx), w2 = __builtin_amdgcn_exp2f(l2 - mx);
        const float inv = 1.0f / (w0 + w1 + w2); w0 *= inv; w1 *= inv; w2 *= inv;
        const size_t off = (size_t)row * AW + h * 128 + 8 * dc;
        const v4u a = *(const GAS v4u*)(AO + off), b = *(const GAS v4u*)(AO + (size_t)M * AW + off), c = *(const GAS v4u*)(AO + (size_t)2 * M * AW + off);
        v4u r;
        r.x = pk2(w0 * bflo(a.x) + w1 * bflo(b.x) + w2 * bflo(c.x), w0 * bfhi(a.x) + w1 * bfhi(b.x) + w2 * bfhi(c.x));
        r.y = pk2(w0 * bflo(a.y) + w1 * bflo(b.y) + w2 * bflo(c.y), w0 * bfhi(a.y) + w1 * bfhi(b.y) + w2 * bfhi(c.y));
        r.z = pk2(w0 * bflo(a.z) + w1 * bflo(b.z) + w2 * bflo(c.z), w0 * bfhi(a.z) + w1 * bfhi(b.z) + w2 * bfhi(c.z));
        r.w = pk2(w0 * bflo(a.w) + w1 * bflo(b.w) + w2 * bflo(c.w), w0 * bfhi(a.w) + w1 * bfhi(b.w) + w2 * bfhi(c.w));
        *(GAS v4u*)(ATT + off) = r;
    }
}

constexpr int HB_STR = 132 * 4, HQ_STR = 264, HQT_STR = 272, HKB_STR = 144, HP_STR = 40;
constexpr int HB_OFF = 0, HQ_OFF = HB_OFF + 64 * HB_STR, HK_OFF = HQ_OFF + 64 * HQ_STR, HQT_OFF = HK_OFF + 64 * HQ_STR, HKB_OFF = HQT_OFF + 64 * HQT_STR, HVT_OFF = HKB_OFF + 128 * HKB_STR,
              HP_OFF = HVT_OFF + 128 * HKB_STR, HD_OFF = HP_OFF + 64 * HP_STR, HBL_OFF = HD_OFF + 2048, H_END = HBL_OFF + 2048;
static_assert(H_END <= LDSCTL_OFF && HQ_OFF % 16 == 0 && HK_OFF % 16 == 0 && HQT_OFF % 16 == 0 && HKB_OFF % 16 == 0 && HVT_OFF % 16 == 0 && HP_OFF % 16 == 0 && HD_OFF % 16 == 0, "hgrn LDS");
typedef short s16x4 __attribute__((ext_vector_type(4)));
#define HG_BAR() do { asm volatile("s_waitcnt lgkmcnt(0)" ::: "memory"); __builtin_amdgcn_s_barrier(); asm volatile("" ::: "memory"); } while (0)
template <bool FULL>
__device__ __forceinline__ void hgrn_pass(LAS unsigned char* lds, const bf16* __restrict__ HBF, const float* __restrict__ LOGF, const float* __restrict__ hnorm, float* __restrict__ SLOC, float* __restrict__ DTOT,
                                          bf16* __restrict__ HG, int bx, int G, int w) {
    const int lane = lane_id_fresh(), tid = w * 64 + lane, fr = lane & 15, fq = lane >> 4;
    const int J1 = tid >> 7, k1 = tid & 127;
    constexpr int NITEM = FULL ? 512 : 448;
    for (int idx = bx; idx < NITEM; idx += G) {
        const int bh = FULL ? (idx >> 3) : (idx / 7), sc = FULL ? ((idx & 256) ? 7 - (idx & 7) : (idx & 7)) : (idx - 7 * (idx / 7)), b = bh >> 3, h = bh & 7;
        const size_t row0 = (size_t)bh * SEQ + (size_t)sc * 256;
        const bf16* HQ = HBF; const bf16* HKEY = HBF + pg8::HB_PART; const bf16* HI = HBF + 2 * pg8::HB_PART; const bf16* HGT = HBF + 3 * pg8::HB_PART;
        f32x4 S[8];
#pragma unroll
        for (int kt = 0; kt < 8; ++kt) S[kt] = (f32x4){0.f, 0.f, 0.f, 0.f};
        if (FULL) {
            for (int m = 0; m < sc; ++m) {
                const float* dt = DTOT + (size_t)(bh * 8 + m) * 128; const float* sl = SLOC + ((size_t)(bh * 8 + m) * 64 + w * 8) * 256 + lane * 4;
#pragma unroll
                for (int kt = 0; kt < 8; ++kt) { const f32x4 dv = *(const GAS f32x4*)(dt + 16 * kt + 4 * fq); const f32x4 sv = *(const GAS f32x4*)(sl + kt * 256); S[kt] = S[kt] * dv + sv; }
            }
        }
        float dsum = 0.f;
        float lf[16]; unsigned kr[16], vr[16], qr[16];
#define HG_LOAD(chn) do { const size_t rJ_ = row0 + 64 * (chn) + 16 * J1; \
        _Pragma("unroll") for (int t = 0; t < 16; ++t) { lf[t] = LOGF[(rJ_ + t) * 128 + k1]; kr[t] = *(const GAS unsigned short*)(HKEY + (rJ_ + t) * 128 + k1); vr[t] = *(const GAS unsigned short*)(HI + (rJ_ + t) * 128 + k1); \
            if (FULL) qr[t] = *(const GAS unsigned short*)(HQ + (rJ_ + t) * 128 + k1); } } while (0)
        HG_LOAD(0);
#pragma unroll 1
        for (int ch = 0; ch < 4; ++ch) {
            const size_t crow0 = row0 + 64 * ch;
            {
                float bb[16]; float run = 0.f;
#pragma unroll
                for (int t = 0; t < 16; ++t) { run += lf[t]; bb[t] = run; }
                unsigned kbw[8], ivw[8];
#pragma unroll
                for (int t = 0; t < 16; t += 2) {
                    const float kfa = __uint_as_float(kr[t] << 16), kfb = __uint_as_float(kr[t + 1] << 16);
                    kbw[t >> 1] = pk2(kfa * __builtin_amdgcn_exp2f(run - bb[t]), kfb * __builtin_amdgcn_exp2f(run - bb[t + 1]));
                    ivw[t >> 1] = vr[t] | (vr[t + 1] << 16);
                    if (FULL) {
                        const float qfa = __uint_as_float(qr[t] << 16), qfb = __uint_as_float(qr[t + 1] << 16);
                        const int ta = 16 * J1 + t;
                        *(LAS float*)(lds + HB_OFF + ta * HB_STR + k1 * 4) = bb[t]; *(LAS float*)(lds + HB_OFF + (ta + 1) * HB_STR + k1 * 4) = bb[t + 1];
                        *(LAS unsigned short*)(lds + HQ_OFF + ta * HQ_STR + k1 * 2) = (unsigned short)qr[t]; *(LAS unsigned short*)(lds + HQ_OFF + (ta + 1) * HQ_STR + k1 * 2) = (unsigned short)qr[t + 1];
                        *(LAS unsigned short*)(lds + HK_OFF + ta * HQ_STR + k1 * 2) = (unsigned short)kr[t]; *(LAS unsigned short*)(lds + HK_OFF + (ta + 1) * HQ_STR + k1 * 2) = (unsigned short)kr[t + 1];
                        const unsigned qtw = pk2(qfa * __builtin_amdgcn_exp2f(bb[t]), qfb * __builtin_amdgcn_exp2f(bb[t + 1]));
                        *(LAS unsigned short*)(lds + HQT_OFF + ta * HQT_STR + k1 * 2) = (unsigned short)(qtw & 0xffffu);
                        *(LAS unsigned short*)(lds + HQT_OFF + (ta + 1) * HQT_STR + k1 * 2) = (unsigned short)(qtw >> 16);
                    }
                }
                *(LAS v4u*)(lds + HKB_OFF + k1 * HKB_STR + J1 * 32) = (v4u){kbw[0], kbw[1], kbw[2], kbw[3]}; *(LAS v4u*)(lds + HKB_OFF + k1 * HKB_STR + J1 * 32 + 16) = (v4u){kbw[4], kbw[5], kbw[6], kbw[7]};
                *(LAS v4u*)(lds + HVT_OFF + k1 * HKB_STR + J1 * 32) = (v4u){ivw[0], ivw[1], ivw[2], ivw[3]}; *(LAS v4u*)(lds + HVT_OFF + k1 * HKB_STR + J1 * 32 + 16) = (v4u){ivw[4], ivw[5], ivw[6], ivw[7]};
                *(LAS float*)(lds + HD_OFF + (J1 * 128 + k1) * 4) = __builtin_amdgcn_exp2f(run);
                if (!FULL) *(LAS float*)(lds + HBL_OFF + (J1 * 128 + k1) * 4) = run;
                if (FULL && tid < 160) *(LAS v4u*)(lds + HP_OFF + tid * 16) = (v4u){0u, 0u, 0u, 0u};
            }
            if (ch < 3) HG_LOAD(ch + 1);
            v4u g0, g1;
            if (FULL) { const bf16* gp = HGT + (crow0 + (tid >> 3)) * 128 + 16 * (tid & 7); g0 = *(const GAS v4u*)gp; g1 = *(const GAS v4u*)(gp + 8); }
            HG_BAR();
            if (FULL) {
#pragma unroll 1
                for (int rr = 0; rr < 3; ++rr) {
                    const int hp = tid + 512 * rr;
                    if (rr < 2 || w == 0) {
                        const int pr = hp >> 1, half = hp & 1, J = pr / 136, pp = pr - 136 * J;
                        int t = (int)((__builtin_sqrtf(8.0f * (float)pp + 1.0f) - 1.0f) * 0.5f);
                        if ((t + 1) * (t + 2) / 2 <= pp) ++t;
                        if (t * (t + 1) / 2 > pp) --t;
                        const int s2 = pp - t * (t + 1) / 2;
                        const LAS unsigned char* bt = lds + HB_OFF + (16 * J + t) * HB_STR + half * 256; const LAS unsigned char* bs = lds + HB_OFF + (16 * J + s2) * HB_STR + half * 256;
                        const LAS unsigned char* qp = lds + HQ_OFF + (16 * J + t) * HQ_STR + half * 128; const LAS unsigned char* kp = lds + HK_OFF + (16 * J + s2) * HQ_STR + half * 128;
                        float a0 = 0.f, a1 = 0.f;
#pragma unroll 4
                        for (int kk = 0; kk < 16; ++kk) {
                            const f32x4 b1 = *(const LAS f32x4*)(bt + kk * 16), b2 = *(const LAS f32x4*)(bs + kk * 16);
                            const u32x2 qw = *(const LAS u32x2*)(qp + kk * 8), kw = *(const LAS u32x2*)(kp + kk * 8);
                            a0 += bflo(qw.x) * bflo(kw.x) * __builtin_amdgcn_exp2f(b1[0] - b2[0]); a1 += bfhi(qw.x) * bfhi(kw.x) * __builtin_amdgcn_exp2f(b1[1] - b2[1]);
                            a0 += bflo(qw.y) * bflo(kw.y) * __builtin_amdgcn_exp2f(b1[2] - b2[2]); a1 += bfhi(qw.y) * bfhi(kw.y) * __builtin_amdgcn_exp2f(b1[3] - b2[3]);
                        }
                        float a = a0 + a1; a += __shfl_xor(a, 1);
                        if (half == 0) *(LAS unsigned short*)(lds + HP_OFF + (16 * J + t) * HP_STR + s2 * 2) = (unsigned short)(pk2(a, 0.f) & 0xffffu);
                    }
                }
                HG_BAR();
            }
#pragma unroll 1
            for (int J = 0; J < 4; ++J) {
                const s16x4 vb = *(const LAS s16x4*)(lds + HVT_OFF + (16 * w + fr) * HKB_STR + (16 * J + 4 * fq) * 2);
                if (FULL) {
                    f32x4 o = (f32x4){0.f, 0.f, 0.f, 0.f};
#pragma unroll
                    for (int kk = 0; kk < 4; ++kk) {
                        const LAS unsigned char* qr = lds + HQT_OFF + (16 * J + fr) * HQT_STR + (32 * kk + 4 * fq) * 2;
                        const u32x2 lo = *(const LAS u32x2*)qr, hi = *(const LAS u32x2*)(qr + 32);
                        const bf16x8 qa = __builtin_bit_cast(bf16x8, (v4u){lo.x, lo.y, hi.x, hi.y});
                        v4u sw; sw.x = pk2(S[2 * kk][0], S[2 * kk][1]); sw.y = pk2(S[2 * kk][2], S[2 * kk][3]); sw.z = pk2(S[2 * kk + 1][0], S[2 * kk + 1][1]); sw.w = pk2(S[2 * kk + 1][2], S[2 * kk + 1][3]);
                        o = __builtin_amdgcn_mfma_f32_16x16x32_bf16(qa, __builtin_bit_cast(bf16x8, sw), o, 0, 0, 0);
                    }
                    const s16x4 pa = *(const LAS s16x4*)(lds + HP_OFF + (16 * J + fr) * HP_STR + 4 * fq * 2);
                    o = __builtin_amdgcn_mfma_f32_16x16x16bf16_1k(pa, vb, o, 0, 0, 0);
#pragma unroll
                    for (int i = 0; i < 4; ++i) *(LAS float*)(lds + HB_OFF + (16 * J + 4 * fq + i) * HB_STR + (16 * w + fr) * 4) = o[i];
                }
#pragma unroll
                for (int kt = 0; kt < 8; ++kt) {
                    const f32x4 dv = *(const LAS f32x4*)(lds + HD_OFF + (J * 128 + 16 * kt + 4 * fq) * 4);
                    const s16x4 ka = *(const LAS s16x4*)(lds + HKB_OFF + (16 * kt + fr) * HKB_STR + (16 * J + 4 * fq) * 2);
                    S[kt] = __builtin_amdgcn_mfma_f32_16x16x16bf16_1k(ka, vb, S[kt] * dv, 0, 0, 0);
                }
            }
            if (!FULL && tid < 128) dsum += (*(const LAS float*)(lds + HBL_OFF + tid * 4) + *(const LAS float*)(lds + HBL_OFF + (128 + tid) * 4)) + (*(const LAS float*)(lds + HBL_OFF + (256 + tid) * 4) + *(const LAS float*)(lds + HBL_OFF + (384 + tid) * 4));
            HG_BAR();
            if (FULL) {
                const int t = tid >> 3, vg = tid & 7;
                const LAS unsigned char* op = lds + HB_OFF + t * HB_STR + vg * 64;
                f32x4 ov[4]; float ss = 0.f;
#pragma unroll
                for (int q4 = 0; q4 < 4; ++q4) { ov[q4] = *(const LAS f32x4*)(op + q4 * 16); ss += (ov[q4][0] * ov[q4][0] + ov[q4][1] * ov[q4][1]) + (ov[q4][2] * ov[q4][2] + ov[q4][3] * ov[q4][3]); }
                ss += __shfl_xor(ss, 1); ss += __shfl_xor(ss, 2); ss += __shfl_xor(ss, 4);
                const float r = __builtin_amdgcn_rsqf(ss * (1.0f / 128.0f) + RMS_EPS);
                const float* np = hnorm + 16 * vg;
                const f32x4 n0 = *(const GAS f32x4*)np, n1 = *(const GAS f32x4*)(np + 4), n2 = *(const GAS f32x4*)(np + 8), n3 = *(const GAS f32x4*)(np + 12);
                v4u r0, r1;
                r0.x = pk2(ov[0][0] * r * n0[0] * bflo(g0.x), ov[0][1] * r * n0[1] * bfhi(g0.x)); r0.y = pk2(ov[0][2] * r * n0[2] * bflo(g0.y), ov[0][3] * r * n0[3] * bfhi(g0.y));
                r0.z = pk2(ov[1][0] * r * n1[0] * bflo(g0.z), ov[1][1] * r * n1[1] * bfhi(g0.z)); r0.w = pk2(ov[1][2] * r * n1[2] * bflo(g0.w), ov[1][3] * r * n1[3] * bfhi(g0.w));
                r1.x = pk2(ov[2][0] * r * n2[0] * bflo(g1.x), ov[2][1] * r * n2[1] * bfhi(g1.x)); r1.y = pk2(ov[2][2] * r * n2[2] * bflo(g1.y), ov[2][3] * r * n2[3] * bfhi(g1.y));
                r1.z = pk2(ov[3][0] * r * n3[0] * bflo(g1.z), ov[3][1] * r * n3[1] * bfhi(g1.z)); r1.w = pk2(ov[3][2] * r * n3[2] * bflo(g1.w), ov[3][3] * r * n3[3] * bfhi(g1.w));
                bf16* hp2 = HG + ((size_t)b * SEQ + (size_t)sc * 256 + 64 * ch + t) * HW + h * 128 + 16 * vg;
                *(GAS v4u*)hp2 = r0; *(GAS v4u*)(hp2 + 8) = r1;
                HG_BAR();
            }
        }
        if (!FULL) {
            float* sl = SLOC + ((size_t)(bh * 8 + sc) * 64 + w * 8) * 256 + lane * 4;
#pragma unroll
            for (int kt = 0; kt < 8; ++kt) *(GAS f32x4*)(sl + kt * 256) = S[kt];
            if (tid < 128) DTOT[(size_t)(bh * 8 + sc) * 128 + tid] = __builtin_amdgcn_exp2f(dsum);
        }
    }
}
typedef const __attribute__((address_space(4))) Args* KArgs;
__device__ __forceinline__ KArgs kargs() { KArgs ka = (KArgs)__builtin_amdgcn_kernarg_segment_ptr(); asm volatile("" : "+s"(ka)); return ka; }
__global__ void __launch_bounds__(NWAVES * 64, 2) mk_fwd(Args args) {
    extern __shared__ __attribute__((aligned(16))) unsigned char lds_raw[];
    LAS unsigned char* lds = (LAS unsigned char*)lds_raw;
    const int wave = __builtin_amdgcn_readfirstlane((int)threadIdx.x >> 6);
    const int G = gridDim.x; const int bx = blockIdx.x;
    const int vcu = (G % 8 == 0) ? (bx % 8) * (G / 8) + bx / 8 : bx;
    const int gw = vcu * NWAVES + wave, NGW = G * NWAVES;
    for (int u = wave * 64 + lane_id_fresh(); u < (LDS_BYTES - LDSCTL_OFF) / 4; u += NWAVES * 64) ((LAS unsigned*)(lds + LDSCTL_OFF))[u] = 0u;
    __syncthreads();
    const int lo = args.ph_lo, hi = args.ph_hi;
    XcdBarrier bar; bar.bar = (unsigned*)(args.ws + WS_CTL) + CW_BAR; bar.x = 0; bar.st = nullptr; bar.w = wave;
    if (hi - lo > 1) bar = xcd_barrier_post((unsigned*)(args.ws + WS_CTL) + CW_BAR, (volatile LAS unsigned*)(lds + MISC_OFF) + 8);
#define IN(k) (lo <= (k) && (k) < hi)
#define SEAM() do { if (IN(ph) && IN(ph + 1)) xcd_barrier(bar); ++ph; } while (0)
#define WSP(T, off) ((T*)(ws + (off)))
    int ph = 0;

    if (IN(ph)) {
        const KArgs ka = kargs(); unsigned char* ws = ka->ws; const float* x_in = ka->in[0]; const float* hgrn_lb = ka->in[7];
        pg8::ss_t* ROWSS = WSP(pg8::ss_t, WS_ROWSS); float* LB = WSP(float, WS_LB); bf16* XB = WSP(bf16, WS_XB);
        const int lane = lane_id_fresh();
        LAS float* scr = (LAS float*)(lds + RING_OFF + wave * 16384);
        const ConvSrc CS = conv_src();
        for (int it = gw; it < DEPTH * I_LAYER; it += NGW) conv_item(CS, it, scr, lane);
        for (int row = gw; row < M; row += NGW) {
            const GAS f32x4* xr = (const GAS f32x4*)(x_in + (size_t)row * DM) + lane;
            GAS unsigned long long* xb8 = (GAS unsigned long long*)(XB + (size_t)row * DM) + lane;
            f32x4 v[8]; float s = 0.f;
#pragma unroll
            for (int j = 0; j < 8; ++j) { v[j] = xr[64 * j]; s += (v[j].x * v[j].x + v[j].y * v[j].y) + (v[j].z * v[j].z + v[j].w * v[j].w); }
            s = wave_sum(s);
#pragma unroll
            for (int j = 0; j < 8; ++j) { xb8[64 * j] = (unsigned long long)pk2(v[j].x, v[j].y) | ((unsigned long long)pk2(v[j].z, v[j].w) << 32); }
            if (lane == 0) ROWSS[row] = pg8::ss_fix(s);
        }
        for (int c = gw * 64 + lane; c < 1024; c += NGW * 64) {
            const float a0 = hgrn_lb[c], a1 = hgrn_lb[1024 + c], a2 = hgrn_lb[2048 + c], a3 = hgrn_lb[3072 + c];
            const float mx = fmaxf(fmaxf(a0, a1), fmaxf(a2, a3));
            const float e0 = __expf(a0 - mx), e1 = __expf(a1 - mx), e2 = __expf(a2 - mx), e3 = __expf(a3 - mx);
            const float inv = 1.0f / (e0 + e1 + e2 + e3);
            LB[c] = 0.f; LB[1024 + c] = e1 * inv; LB[2048 + c] = (e1 + e2) * inv; LB[3072 + c] = (e1 + e2 + e3) * inv;
        }
    }
    SEAM();

    for (int i = 0; i < 8; ++i) {
        const int l = i >> 1, s = i & 1;
        {
            if (IN(ph)) {
                unsigned char* ws = kargs()->ws; unsigned char* wl = ws + WS_W + (size_t)l * WL_BYTES;
                pg8::Gemm g{WSP(bf16, WS_XB), (const bf16*)(wl + WO_W1 + s * W1_BYTES), M, NUP, DM}; pg8::StaticOrder S; S.init(M, NUP, G, bx);
                pg8::EpiFfnUp E{WSP(bf16, WS_HFF), WSP(pg8::ss_t, WS_ROWSS) + (size_t)(3 * l + 2 * s) * M};
                pg8::gemm_phase<pg8::EpiFfnUp, pg8::StaticOrder, true, true>(lds + RING_OFF, g, S, E, wave);
            }
            SEAM();
            if (IN(ph)) {
                unsigned char* ws = kargs()->ws; unsigned char* wl = ws + WS_W + (size_t)l * WL_BYTES;
                pg8::Gemm g{WSP(bf16, WS_HFF), (const bf16*)(wl + WO_W2 + s * W2_BYTES), M, DM, DFF}; pg8::StaticOrder S; S.init(M, DM, G, bx);
                pg8::EpiResid E{WSP(bf16, WS_XB), WSP(pg8::ss_t, WS_ROWSS) + (size_t)(3 * l + 2 * s + 1) * M, 0.5f, 2.0f};
                pg8::gemm_phase<pg8::EpiResid, pg8::StaticOrder, true, true>(lds + RING_OFF, g, S, E, wave);
            }
            SEAM();
        }
        if (s == 0) {
            if (IN(ph)) {
                const KArgs ka = kargs(); unsigned char* ws = ka->ws; unsigned char* wl = ws + WS_W + (size_t)l * WL_BYTES;
                pg8::Gemm g{WSP(bf16, WS_XB), (const bf16*)(wl + WO_WIN), M, INW, DM}; pg8::StaticOrder S; S.init(M, INW, G, bx);
                pg8::EpiZ E{WSP(bf16, WS_Z), WSP(bf16, WS_Z + 144 * MiB), WSP(unsigned char, WS_Z + 272 * MiB), WSP(float, WS_LOGF), WSP(pg8::ss_t, WS_ROWSS) + (size_t)(3 * l + 1) * M, WSP(float, WS_LB) + l * 1024, ka->in[6] + (size_t)l * 2 * DM};
                pg8::gemm_phase<pg8::EpiZ, pg8::StaticOrder, true, true>(lds + RING_OFF, g, S, E, wave);
            }
            SEAM();
            if (IN(ph)) {
                unsigned char* ws = kargs()->ws;
                hgrn_pass<false>(lds, WSP(bf16, WS_Z + 144 * MiB), WSP(float, WS_LOGF), nullptr, WSP(float, WS_SLOC), WSP(float, WS_DTOT), nullptr, bx, G, wave);
                attn_fast(lds, WSP(bf16, WS_Z), WSP(bf16, WS_AO), WSP(float, WS_LSE), vcu, G, wave);
            }
            SEAM();
            if (IN(ph)) {
                const KArgs ka = kargs(); unsigned char* ws = ka->ws;
                hgrn_pass<true>(lds, WSP(bf16, WS_Z + 144 * MiB), WSP(float, WS_LOGF), ka->in[8] + l * 128, WSP(float, WS_SLOC), WSP(float, WS_DTOT), WSP(bf16, WS_HG), bx, G, wave);
                attn_combine(WSP(bf16, WS_AO), WSP(float, WS_LSE), WSP(bf16, WS_ATT), gw, NGW);
            }
            SEAM();
            if (IN(ph)) {
                unsigned char* ws = kargs()->ws; unsigned char* wl = ws + WS_W + (size_t)l * WL_BYTES;
                { pg8::Gemm g{WSP(bf16, WS_ATT), (const bf16*)(wl + WO_WPA), M, DM, AW}; pg8::StaticOrder S; S.init(M, DM, G, bx);
                  pg8::EpiPa E{WSP(unsigned char, WS_Z + 272 * MiB), WSP(bf16, WS_Y32)};
                  pg8::gemm_phase<pg8::EpiPa, pg8::StaticOrder, true, true>(lds + RING_OFF, g, S, E, wave); }
                { pg8::Gemm g{WSP(bf16, WS_HG), (const bf16*)(wl + WO_WPM), M, DM, HW}; pg8::StaticOrder S; S.init(M, DM, G, bx);
                  pg8::EpiPm E{WSP(unsigned char, WS_Z + 272 * MiB), WSP(bf16, WS_Y32), WSP(bf16, WS_YB)};
                  pg8::gemm_phase<pg8::EpiPm, pg8::StaticOrder, true, true>(lds + RING_OFF, g, S, E, wave); }
            }
            SEAM();
            if (IN(ph)) {
                unsigned char* ws = kargs()->ws; unsigned char* wl = ws + WS_W + (size_t)l * WL_BYTES;
                pg8::Gemm g{WSP(bf16, WS_YB), (const bf16*)(wl + WO_WO), M, DM, DM}; pg8::StaticOrder S; S.init(M, DM, G, bx);
                pg8::EpiResid E{WSP(bf16, WS_XB), WSP(pg8::ss_t, WS_ROWSS) + (size_t)(3 * l + 2) * M, 1.0f, 1.0f};
                pg8::gemm_phase<pg8::EpiResid, pg8::StaticOrder, true, true>(lds + RING_OFF, g, S, E, wave);
            }
            SEAM();
        }
    }
    if (IN(ph)) {
        const KArgs ka = kargs(); unsigned char* ws = ka->ws; const float* final_norm = ka->in[12]; float* out = ka->out;
        const int lane = lane_id_fresh();
        const pg8::ss_t* rs = WSP(pg8::ss_t, WS_ROWSS) + (size_t)12 * M; const bf16* XB = WSP(bf16, WS_XB);
        for (int row = gw; row < M; row += NGW) {
            const float r = pg8::rstd_of(rs[row]);
            const GAS u32x2* xr = (const GAS u32x2*)(XB + (size_t)row * DM) + lane;
            const GAS f32x4* gn = (const GAS f32x4*)final_norm + lane;
            GAS f32x4* orow = (GAS f32x4*)(out + (size_t)row * DM) + lane;
#pragma unroll
            for (int j = 0; j < 8; ++j) { const u32x2 v = xr[64 * j]; const f32x4 g = gn[64 * j]; orow[64 * j] = (f32x4){bflo(v.x) * r * g.x, bfhi(v.x) * r * g.y, bflo(v.y) * r * g.z, bfhi(v.y) * r * g.w}; }
        }
    }
#undef IN
#undef SEAM
#undef WSP
}

extern "C" void kernel_launch(void* const* d_in, const int* in_sizes, int n_in, void* d_out, int out_size, void* d_ws, size_t ws_size, hipStream_t stream) {
    static int grid = 0;
    if (grid == 0) {
        if (n_in != 13 || in_sizes[0] != M * DM || out_size != M * DM || ws_size < WS_END) { fprintf(stderr, "kernel_launch: unexpected shapes (n_in %d, in0 %d, out %d, ws %zu < %zu?); nothing launched\n", n_in, n_in > 0 ? in_sizes[0] : -1, out_size, ws_size, (size_t)WS_END); grid = -1; return; }
        int dev = 0, cus = 0, per_cu = 0;
        if (hipGetDevice(&dev) != hipSuccess || hipDeviceGetAttribute(&cus, hipDeviceAttributeMultiprocessorCount, dev) != hipSuccess) { grid = -1; return; }
        if (hipFuncSetAttribute((const void*)mk_fwd, hipFuncAttributeMaxDynamicSharedMemorySize, LDS_BYTES) != hipSuccess) { fprintf(stderr, "kernel_launch: hipFuncSetAttribute failed\n"); grid = -1; return; }
        if (hipOccupancyMaxActiveBlocksPerMultiprocessor(&per_cu, (const void*)mk_fwd, NWAVES * 64, LDS_BYTES) != hipSuccess || per_cu < 1) { fprintf(stderr, "kernel_launch: occupancy query says %d blocks per CU\n", per_cu); }
        (void)hipGetLastError();
        grid = cus;
    }
    if (grid < 0) return;
    if (hipMemsetAsync((char*)d_ws + WS_CTL, 0, CTL_ZERO_BYTES, stream) != hipSuccess) { fprintf(stderr, "kernel_launch: memset failed\n"); return; }
    Args a{};
    for (int i = 0; i < 13; ++i) a.in[i] = (const float*)d_in[i];
    a.out = (float*)d_out; a.ws = (unsigned char*)d_ws;
#if MK_ONE_LAUNCH
    a.ph_lo = 0; a.ph_hi = N_PHASES;
    hipLaunchKernelGGL(mk_fwd, dim3(grid), dim3(NWAVES * 64), LDS_BYTES, stream, a);
#else
    for (int p = 0; p < N_PHASES; ++p) { a.ph_lo = p; a.ph_hi = p + 1; hipLaunchKernelGGL(mk_fwd, dim3(grid), dim3(NWAVES * 64), LDS_BYTES, stream, a); }
#endif
    const hipError_t le = hipPeekAtLastError();
    if (le != hipSuccess) fprintf(stderr, "kernel_launch: launch failed: %s\n", hipGetErrorName(le));
}
```

```cpp
#include <hip/hip_runtime.h>
#include <cstdio>
#include <cstdint>
namespace pg8 {
#define PG8_LAS __attribute__((address_space(3)))
typedef unsigned short bf16_t;
typedef short bf16x8 __attribute__((ext_vector_type(8)));
typedef float f32x4 __attribute__((ext_vector_type(4)));
typedef unsigned u32x4 __attribute__((ext_vector_type(4)));
constexpr int BM = 256, BK = 64, HALF = 128, HTB = HALF * BK * 2  , STAGE_BYTES = 8 * HTB, NXCD = 8, WGM = 8;

__host__ __device__ __forceinline__ int lds_byte(int r, int c) { const int st = (r >> 4) * 2 + (c >> 5), rr = r & 15, cc = c & 31, ob = rr * 64 + cc * 2; return st * 1024 + (ob ^ (((ob >> 9) & 1) << 5)); }
__host__ __device__ __forceinline__ void stage_rc(int b, int& R, int& C) { const int st = b / 1024, sb = b % 1024, swz = sb ^ (((sb >> 9) & 1) << 5); R = (st >> 1) * 16 + swz / 64; C = (st & 1) * 32 + (swz % 64) / 2; }
__host__ __device__ __forceinline__ int perm32(int rho) { const int n = rho >> 4, i = rho & 15; return 8 * (i >> 2) + 4 * n + (i & 3); }

struct Unit { int pm, pn; };
struct Gemm { const bf16_t* A; const bf16_t* Bt; int M, N, K; };

struct StaticOrder {
    int nM, nN, nwg, G, c;
    __host__ __device__ void init(int M, int N, int G_, int c_) { nM = M / BM; nN = N / BM; nwg = nM * nN; G = G_; c = c_; }
    __host__ __device__ bool next(int i, Unit& u) const {
        const long L = (long)i * G + c; if (L >= nwg) return false;
        int wgid = (int)L; { const int q = nwg / NXCD, r = nwg % NXCD, xcd = wgid % NXCD, off = wgid / NXCD; wgid = (xcd < r ? xcd * (q + 1) : r * (q + 1) + (xcd - r) * q) + off; }
        const int nig = WGM * nN, gid = wgid / nig, fm = gid * WGM, gsz = (nM - fm) < WGM ? (nM - fm) : WGM;
        u.pm = fm + ((wgid % nig) % gsz); u.pn = (wgid % nig) / gsz; return true;
    }
    __device__ __forceinline__ void a_ready(const Unit&) const {}
    __device__ __forceinline__ void done(const Unit&) const {}
};
typedef __bf16 bf16x2_t __attribute__((ext_vector_type(2)));
typedef float f32x2_t __attribute__((ext_vector_type(2)));
__device__ __forceinline__ unsigned cvt_pk_bf16(float lo, float hi) { const f32x2_t v = {lo, hi}; const bf16x2_t b = __builtin_convertvector(v, bf16x2_t); return __builtin_bit_cast(unsigned, b); }
constexpr float RMS_EPS = 1e-6f;
constexpr int DM = 2048, DFF = 5504, INW = 12800;
typedef unsigned long long ss_t;
__device__ __forceinline__ ss_t ss_fix(float ss) { return (ss_t)(ss * 4294967296.0f); }
__device__ __forceinline__ float rstd_of(ss_t ss) { return __builtin_amdgcn_rsqf((float)ss * (1.0f / 4294967296.0f / 2048.0f) + RMS_EPS); }
__device__ __forceinline__ float sigmoid_f(float x) { return __builtin_amdgcn_rcpf(1.0f + __expf(-x)); }
__device__ __forceinline__ float silu_f(float x) { return x * sigmoid_f(x); }
typedef unsigned u32x2 __attribute__((ext_vector_type(2)));
__device__ __forceinline__ int lane_id_fresh() { int l; asm volatile("v_mbcnt_lo_u32_b32 %0, -1, 0\n\tv_mbcnt_hi_u32_b32 %0, -1, %0" : "=v"(l)); return l; }
__device__ __forceinline__ float ub0(unsigned w) { return (float)(w & 0xffu); }
__device__ __forceinline__ float ub1(unsigned w) { return (float)((w >> 8) & 0xffu); }
__device__ __forceinline__ float ub2(unsigned w) { return (float)((w >> 16) & 0xffu); }
__device__ __forceinline__ float ub3(unsigned w) { return (float)(w >> 24); }
__device__ __forceinline__ float bflo(unsigned w) { return __uint_as_float(w << 16); }
__device__ __forceinline__ float bfhi(unsigned w) { return __uint_as_float(w & 0xffff0000u); }

struct EpiFfnUp {
    static constexpr bool PERM = true, AFTER_DRAIN = false;
    struct State { ss_t rs[8]; };
    bf16_t* H; const ss_t* rowss;
    __device__ __forceinline__ void init(f32x4 (&acc)[2][2][4][2], State& st, const Unit& u, int wr, int wc, int fr, int fq) const {
#pragma unroll
        for (int ai = 0; ai < 2; ++ai)
#pragma unroll
            for (int m = 0; m < 4; ++m) st.rs[ai * 4 + m] = rowss[u.pm * BM + wr * 64 + fr + ai * HALF + m * 16];
#pragma unroll
        for (int a = 0; a < 2; ++a)
#pragma unroll
            for (int b = 0; b < 2; ++b)
#pragma unroll
                for (int m = 0; m < 4; ++m)
#pragma unroll
                    for (int n = 0; n < 2; ++n) acc[a][b][m][n] = (f32x4){0.f, 0.f, 0.f, 0.f};
    }
    __device__ __forceinline__ void operator()(const f32x4 (&acc)[2][2][4][2], const State& st, const Unit& u, int wr, int wc, int fr, int fq) const {
        const int row0 = u.pm * BM + wr * 64 + fr, col0 = u.pn * 128 + wc * 32 + 8 * fq;
#pragma unroll
        for (int ai = 0; ai < 2; ++ai)
#pragma unroll
            for (int m = 0; m < 4; ++m) {
                const int row = row0 + ai * HALF + m * 16; const float rs = rstd_of(st.rs[ai * 4 + m]);
                float h[8];
#pragma unroll
                for (int n = 0; n < 2; ++n)
#pragma unroll
                    for (int j = 0; j < 4; ++j) { const float g = rs * acc[ai][0][m][n][j], up = rs * acc[ai][1][m][n][j]; h[4 * n + j] = silu_f(g) * up; }
                u32x4 w; w.x = cvt_pk_bf16(h[0], h[1]); w.y = cvt_pk_bf16(h[2], h[3]); w.z = cvt_pk_bf16(h[4], h[5]); w.w = cvt_pk_bf16(h[6], h[7]);
                *(u32x4*)(H + (size_t)row * DFF + col0) = w;
            }
    }
};
struct EpiResid {
    static constexpr bool PERM = true, AFTER_DRAIN = false;
    struct State {};
    bf16_t* XB; ss_t* rowss_out; float scale, inv_scale;
    __device__ __forceinline__ void init(f32x4 (&acc)[2][2][4][2], State&, const Unit& u, int wr, int wc, int fr, int fq) const {
        const int row0 = u.pm * BM + wr * 64 + fr, col0 = u.pn * BM + wc * 32 + 8 * fq;
#pragma unroll
        for (int ai = 0; ai < 2; ++ai)
#pragma unroll
            for (int m = 0; m < 4; ++m)
#pragma unroll
                for (int bj = 0; bj < 2; ++bj) {
                    const u32x4 xw = *(const u32x4*)(XB + (size_t)(row0 + ai * HALF + m * 16) * DM + col0 + bj * HALF);
                    acc[ai][bj][m][0] = (f32x4){bflo(xw.x), bfhi(xw.x), bflo(xw.y), bfhi(xw.y)} * inv_scale; acc[ai][bj][m][1] = (f32x4){bflo(xw.z), bfhi(xw.z), bflo(xw.w), bfhi(xw.w)} * inv_scale;
                }
    }
    __device__ __forceinline__ void operator()(const f32x4 (&acc)[2][2][4][2], const State& st, const Unit& u, int wr, int wc, int fr, int fq) const {
        const int row0 = u.pm * BM + wr * 64 + fr, col0 = u.pn * BM + wc * 32 + 8 * fq;
#pragma unroll
        for (int ai = 0; ai < 2; ++ai)
#pragma unroll
            for (int m = 0; m < 4; ++m) {
                const int row = row0 + ai * HALF + m * 16; float ss = 0.f;
#pragma unroll
                for (int bj = 0; bj < 2; ++bj) {
                    const f32x4 x0 = acc[ai][bj][m][0] * scale, x1 = acc[ai][bj][m][1] * scale;
                    u32x4 w; w.x = cvt_pk_bf16(x0[0], x0[1]); w.y = cvt_pk_bf16(x0[2], x0[3]); w.z = cvt_pk_bf16(x1[0], x1[1]); w.w = cvt_pk_bf16(x1[2], x1[3]);
                    *(u32x4*)(XB + (size_t)row * DM + col0 + bj * HALF) = w;
                    ss += (x0[0] * x0[0] + x0[1] * x0[1]) + (x0[2] * x0[2] + x0[3] * x0[3]) + (x1[0] * x1[0] + x1[1] * x1[1]) + (x1[2] * x1[2] + x1[3] * x1[3]);
                }
                ss += __shfl_xor(ss, 16); ss += __shfl_xor(ss, 32);
                if (fq == 0) __hip_atomic_fetch_add(rowss_out + row, ss_fix(ss), __ATOMIC_RELAXED, __HIP_MEMORY_SCOPE_AGENT);
            }
    }
};
constexpr float QSCALE = 0.08838834764831845f * 1.4426950408889634f;
constexpr int ZC_QA = 0, ZC_KA = 1536, ZC_VA = 3072, ZC_QH = 4608, ZC_FH = 5632, ZC_IH = 6656, ZC_GH = 7680, ZC_GA = 8704, ZC_GM = 10752;
constexpr int M_ROWS = 16384, SEQ_LEN = 2048;
constexpr size_t QKV_PART = (size_t)M_ROWS * 1536, HB_PART = (size_t)M_ROWS * 1024;
struct EpiZ {
    static constexpr bool PERM = true, AFTER_DRAIN = false;
    struct State { ss_t rs[8]; };
    bf16_t* QKV; bf16_t* HB; unsigned char* GATES; float* LOGF; const ss_t* rowss; const float* lb; const float* bgate;
    __device__ __forceinline__ void init(f32x4 (&acc)[2][2][4][2], State& st, const Unit& u, int wr, int wc, int fr, int fq) const {
#pragma unroll
        for (int ai = 0; ai < 2; ++ai)
#pragma unroll
            for (int m = 0; m < 4; ++m) st.rs[ai * 4 + m] = rowss[u.pm * BM + wr * 64 + fr + ai * HALF + m * 16];
#pragma unroll
        for (int a = 0; a < 2; ++a)
#pragma unroll
            for (int b = 0; b < 2; ++b)
#pragma unroll
                for (int m = 0; m < 4; ++m)
#pragma unroll
                    for (int n = 0; n < 2; ++n) acc[a][b][m][n] = (f32x4){0.f, 0.f, 0.f, 0.f};
    }
    __device__ __forceinline__ void operator()(const f32x4 (&acc)[2][2][4][2], const State& st, const Unit& u, int wr, int wc, int fr, int fq) const {
        const int pn = u.pn;
        const int mode = pn < 6 ? 0 : pn < 18 ? 1 : pn < 22 ? 2 : pn < 26 ? 3 : pn < 30 ? 1 : pn < 34 ? 2 : 4;
        const int region = pn < 18 ? 0 : pn < 34 ? 1 : 2;
        const int row0 = u.pm * BM + wr * 64 + fr, colb = pn * BM + wc * 32 + 8 * fq;
#pragma unroll
        for (int bj = 0; bj < 2; ++bj) {
            float par[8];
            {
                f32x4 p0 = (f32x4){0.f, 0.f, 0.f, 0.f}, p1 = p0;
                if (mode == 3) { const float* p = lb + (colb + bj * HALF - ZC_FH); p0 = *(const f32x4*)p; p1 = *(const f32x4*)(p + 4); }
                if (mode == 4) { const float* p = bgate + (colb + bj * HALF - ZC_GA); p0 = *(const f32x4*)p; p1 = *(const f32x4*)(p + 4); }
#pragma unroll
                for (int j = 0; j < 4; ++j) { par[j] = p0[j]; par[4 + j] = p1[j]; }
            }
            const int c0 = colb + bj * HALF;
#pragma unroll
            for (int ai = 0; ai < 2; ++ai)
#pragma unroll
                for (int m = 0; m < 4; ++m) {
                    const int row = row0 + ai * HALF + m * 16; const float rs = rstd_of(st.rs[ai * 4 + m]);
                    const int b = row >> 11, t = row & (SEQ_LEN - 1);
                    float v[8];
#pragma unroll
                    for (int n = 0; n < 2; ++n)
#pragma unroll
                        for (int j = 0; j < 4; ++j) v[4 * n + j] = rs * acc[ai][bj][m][n][j];
                    bf16_t* dst;
                    if (region == 0) {
                        const int part = c0 / 1536, cip = c0 - part * 1536, g = cip >> 9, hh = (cip >> 7) & 3, d = cip & 127, sh = 2 * g;
                        const int pt = ((t & ((1 << sh) - 1)) << (11 - sh)) + (t >> sh);
                        dst = QKV + (size_t)part * QKV_PART + ((size_t)(((b * 3 + g) * 4 + hh) * SEQ_LEN + pt) * 128 + d);
                    } else if (region == 1) {
                        const int hp = (c0 - ZC_QH) >> 10, cip = (c0 - ZC_QH) & 1023, hh = cip >> 7, k = cip & 127;
                        const size_t off = (size_t)((b * 8 + hh) * SEQ_LEN + t) * 128 + k;
                        dst = HB + (size_t)hp * HB_PART + off;
                        if (mode == 3) {
                            float lg[8];
#pragma unroll
                            for (int j = 0; j < 8; ++j) { const float l = par[j], fl = v[j]; const float sg = sigmoid_f(fl); lg[j] = __builtin_amdgcn_logf(l + (1.0f - l) * sg); v[j] = (1.0f - l) * __builtin_amdgcn_rcpf(1.0f + __expf(fl)); }
                            float* lp = LOGF + off;
                            *(f32x4*)lp = (f32x4){lg[0], lg[1], lg[2], lg[3]}; *(f32x4*)(lp + 4) = (f32x4){lg[4], lg[5], lg[6], lg[7]};
                        }
                    } else {
                        unsigned q[8];
#pragma unroll
                        for (int j = 0; j < 8; ++j) q[j] = (unsigned)(sigmoid_f(v[j] + par[j]) * 255.0f + 0.5f);
                        u32x2 gw8; gw8.x = q[0] | (q[1] << 8) | (q[2] << 16) | (q[3] << 24); gw8.y = q[4] | (q[5] << 8) | (q[6] << 16) | (q[7] << 24);
                        *(u32x2*)(GATES + (size_t)row * 4096 + (c0 - ZC_GA)) = gw8;
                        continue;
                    }
                    if (mode == 0) {
#pragma unroll
                        for (int j = 0; j < 8; ++j) v[j] *= QSCALE;
                    } else if (mode == 2) {
#pragma unroll
                        for (int j = 0; j < 8; ++j) v[j] = silu_f(v[j]);
                    }
                    u32x4 w; w.x = cvt_pk_bf16(v[0], v[1]); w.y = cvt_pk_bf16(v[2], v[3]); w.z = cvt_pk_bf16(v[4], v[5]); w.w = cvt_pk_bf16(v[6], v[7]);
                    *(u32x4*)dst = w;
                }
        }
    }
};
struct EpiPa {
    static constexpr bool PERM = true, AFTER_DRAIN = false;
    struct State {};
    const unsigned char* GATES; bf16_t* YA;
    __device__ __forceinline__ void init(f32x4 (&acc)[2][2][4][2], State&, const Unit&, int, int, int, int) const {
#pragma unroll
        for (int a = 0; a < 2; ++a)
#pragma unroll
            for (int b = 0; b < 2; ++b)
#pragma unroll
                for (int m = 0; m < 4; ++m)
#pragma unroll
                    for (int n = 0; n < 2; ++n) acc[a][b][m][n] = (f32x4){0.f, 0.f, 0.f, 0.f};
    }
    __device__ __forceinline__ void operator()(const f32x4 (&acc)[2][2][4][2], const State& st, const Unit& u, int wr, int wc, int fr, int fq) const {
        const int row0 = u.pm * BM + wr * 64 + fr, col0 = u.pn * BM + wc * 32 + 8 * fq;
        u32x2 g[2][4][2];
#pragma unroll
        for (int ai = 0; ai < 2; ++ai)
#pragma unroll
            for (int m = 0; m < 4; ++m)
#pragma unroll
                for (int bj = 0; bj < 2; ++bj) g[ai][m][bj] = *(const u32x2*)(GATES + (size_t)(row0 + ai * HALF + m * 16) * 4096 + col0 + bj * HALF);
#pragma unroll
        for (int ai = 0; ai < 2; ++ai)
#pragma unroll
            for (int m = 0; m < 4; ++m)
#pragma unroll
                for (int bj = 0; bj < 2; ++bj) {
                    const u32x2 gg = g[ai][m][bj]; const f32x4 a0 = acc[ai][bj][m][0] * (1.0f / 255.0f), a1 = acc[ai][bj][m][1] * (1.0f / 255.0f);
                    u32x4 w; w.x = cvt_pk_bf16(ub0(gg.x) * a0[0], ub1(gg.x) * a0[1]); w.y = cvt_pk_bf16(ub2(gg.x) * a0[2], ub3(gg.x) * a0[3]);
                    w.z = cvt_pk_bf16(ub0(gg.y) * a1[0], ub1(gg.y) * a1[1]); w.w = cvt_pk_bf16(ub2(gg.y) * a1[2], ub3(gg.y) * a1[3]);
                    *(u32x4*)(YA + (size_t)(row0 + ai * HALF + m * 16) * DM + col0 + bj * HALF) = w;
                }
    }
};
struct EpiPm {
    static constexpr bool PERM = true, AFTER_DRAIN = false;
    struct State {};
    const unsigned char* GATES; const bf16_t* YA; bf16_t* YB;
    __device__ __forceinline__ void init(f32x4 (&acc)[2][2][4][2], State&, const Unit&, int, int, int, int) const {
#pragma unroll
        for (int a = 0; a < 2; ++a)
#pragma unroll
            for (int b = 0; b < 2; ++b)
#pragma unroll
                for (int m = 0; m < 4; ++m)
#pragma unroll
                    for (int n = 0; n < 2; ++n) acc[a][b][m][n] = (f32x4){0.f, 0.f, 0.f, 0.f};
    }
    __device__ __forceinline__ void operator()(const f32x4 (&acc)[2][2][4][2], const State& st, const Unit& u, int wr, int wc, int fr, int fq) const {
        const int row0 = u.pm * BM + wr * 64 + fr, col0 = u.pn * BM + wc * 32 + 8 * fq;
#pragma unroll
        for (int ai = 0; ai < 2; ++ai) {
            u32x2 g[4][2]; u32x4 y[4][2];
#pragma unroll
            for (int m = 0; m < 4; ++m)
#pragma unroll
                for (int bj = 0; bj < 2; ++bj) {
                    g[m][bj] = *(const u32x2*)(GATES + (size_t)(row0 + ai * HALF + m * 16) * 4096 + 2048 + col0 + bj * HALF);
                    y[m][bj] = *(const u32x4*)(YA + (size_t)(row0 + ai * HALF + m * 16) * DM + col0 + bj * HALF);
                }
#pragma unroll
            for (int m = 0; m < 4; ++m)
#pragma unroll
                for (int bj = 0; bj < 2; ++bj) {
                    const u32x2 gg = g[m][bj]; const u32x4 yy = y[m][bj]; const f32x4 a0 = acc[ai][bj][m][0] * (1.0f / 255.0f), a1 = acc[ai][bj][m][1] * (1.0f / 255.0f);
                    u32x4 w;
                    w.x = cvt_pk_bf16(bflo(yy.x) + ub0(gg.x) * a0[0], bfhi(yy.x) + ub1(gg.x) * a0[1]); w.y = cvt_pk_bf16(bflo(yy.y) + ub2(gg.x) * a0[2], bfhi(yy.y) + ub3(gg.x) * a0[3]);
                    w.z = cvt_pk_bf16(bflo(yy.z) + ub0(gg.y) * a1[0], bfhi(yy.z) + ub1(gg.y) * a1[1]); w.w = cvt_pk_bf16(bflo(yy.w) + ub2(gg.y) * a1[2], bfhi(yy.w) + ub3(gg.y) * a1[3]);
                    *(u32x4*)(YB + (size_t)(row0 + ai * HALF + m * 16) * DM + col0 + bj * HALF) = w;
                }
        }
    }
};
template <class Epi, class Sched, bool ALIGN_EPI = false, bool SP2 = false>
__device__ __forceinline__ void gemm_phase(PG8_LAS unsigned char* lds, const Gemm g, const Sched& S, const Epi& E, int wave_id) {
    int wid_l = wave_id; asm volatile("" : "+s"(wid_l));
    const int lane = lane_id_fresh(), wid = wid_l, tid = wid * 64 + lane, wr = wid >> 2, wc = wid & 3, fr = lane & 15, fq = lane >> 4;
    const int K = g.K, nt = K / BK;
    unsigned voffA[2], voffB[2];
#pragma unroll
    for (int i = 0; i < 2; ++i) { int R, C; stage_rc(tid * 16 + i * 8192, R, C); const int Rb = Epi::PERM ? ((R & ~31) + perm32(R & 31)) : R;
        voffA[i] = (unsigned)(R * K + C) * 2u; voffB[i] = (unsigned)(Rb * K + C) * 2u; }
    const size_t kstep = (size_t)(BK * 2);
    const size_t hstep = (size_t)HALF * K * 2;
    const size_t tstep = 2 * hstep;
    const unsigned ldsw = (unsigned)wid * 1024u;
    const int aoff = lds_byte(wr * 64 + fr, fq * 8), boff = lds_byte(wc * 32 + fr, fq * 8);
#define PG8_SA(b, h) (((b) * 2 + (h)) * HTB)
#define PG8_SB(b, h) ((4 + (b) * 2 + (h)) * HTB)
#define PG8_STAGE(bufoff, gbase, voff) do { _Pragma("unroll") for (int _i = 0; _i < 2; ++_i) \
        __builtin_amdgcn_global_load_lds((const unsigned*)((const char*)(gbase) + (voff)[_i]), (PG8_LAS unsigned*)(lds + (bufoff) + ldsw + _i * 8192), 16, 0, 0); } while (0)
#define PG8_LDA(dst, b, h) do { _Pragma("unroll") for (int m = 0; m < 4; ++m) _Pragma("unroll") for (int k = 0; k < 2; ++k) dst[m][k] = *(const PG8_LAS bf16x8*)(lds + PG8_SA(b, h) + aoff + m * 2048 + k * 1024); } while (0)
#define PG8_LDB(dst, b, h) do { _Pragma("unroll") for (int n = 0; n < 2; ++n) _Pragma("unroll") for (int k = 0; k < 2; ++k) dst[n][k] = *(const PG8_LAS bf16x8*)(lds + PG8_SB(b, h) + boff + n * 2048 + k * 1024); } while (0)
#define PG8_MMA(ai, bj, At, Bt) do { __builtin_amdgcn_s_setprio(1); _Pragma("unroll") for (int m = 0; m < 4; ++m) _Pragma("unroll") for (int n = 0; n < 2; ++n) _Pragma("unroll") for (int k = 0; k < 2; ++k) \
        acc[ai][bj][m][n] = __builtin_amdgcn_mfma_f32_16x16x32_bf16(Bt[n][k], At[m][k], acc[ai][bj][m][n], 0, 0, 0); __builtin_amdgcn_s_setprio(0); } while (0)
#define PG8_WAIT_V(n) asm volatile("s_waitcnt vmcnt(" #n ")" ::: "memory")
#define PG8_WAIT_L(n) asm volatile("s_waitcnt lgkmcnt(" #n ")" ::: "memory")
#define PG8_BAR __builtin_amdgcn_s_barrier()
#define PG8_SCHED __builtin_amdgcn_sched_barrier(0)
    Unit cur, nxt; int ui = 0;
    if (!S.next(0, cur)) return;
    f32x4 acc[2][2][4][2]; typename Epi::State est;
    E.init(acc, est, cur, wr, wc, fr, fq);
    bf16x8 At[4][2], B0[2][2], B1[2][2];
    const char* cA = (const char*)g.A + (size_t)cur.pm * tstep; const char* cB = (const char*)g.Bt + (size_t)cur.pn * tstep;
    S.a_ready(cur);
    if constexpr (SP2) {
        PG8_STAGE(PG8_SB(0, 0), cB, voffB); PG8_STAGE(PG8_SB(0, 1), cB + hstep, voffB); PG8_STAGE(PG8_SA(0, 0), cA, voffA); PG8_STAGE(PG8_SA(0, 1), cA + hstep, voffA);
        if (wr == 1) PG8_BAR;
        PG8_WAIT_V(2); PG8_BAR;
        PG8_STAGE(PG8_SB(1, 0), cB + kstep, voffB); PG8_STAGE(PG8_SA(1, 0), cA + kstep, voffA); PG8_STAGE(PG8_SB(1, 1), cB + hstep + kstep, voffB);
        PG8_WAIT_V(6); PG8_BAR;
    } else {
        PG8_STAGE(PG8_SB(0, 0), cB, voffB); PG8_STAGE(PG8_SA(0, 0), cA, voffA); PG8_STAGE(PG8_SB(0, 1), cB + hstep, voffB); PG8_STAGE(PG8_SA(0, 1), cA + hstep, voffA);
        if (wr == 1) PG8_BAR;
        PG8_WAIT_V(4); PG8_BAR;
        PG8_STAGE(PG8_SB(1, 0), cB + kstep, voffB); PG8_STAGE(PG8_SA(1, 0), cA + kstep, voffA); PG8_STAGE(PG8_SB(1, 1), cB + hstep + kstep, voffB);
        PG8_WAIT_V(6); PG8_BAR;
    }
    for (;;) {
        const bool has_next = S.next(ui + 1, nxt);
        const char* nA = has_next ? (const char*)g.A + (size_t)nxt.pm * tstep : cA; const char* nB = has_next ? (const char*)g.Bt + (size_t)nxt.pn * tstep : cB;
        for (int t = 0; t < nt; t += 2) {
            const bool last = (t == nt - 2);
            const char* a1 = cA + (size_t)(t + 1) * kstep;
            const char* a2 = last ? nA : cA + (size_t)(t + 2) * kstep; const char* b2 = last ? nB : cB + (size_t)(t + 2) * kstep;
            const char* a3 = a2 + kstep; const char* b3 = b2 + kstep;
            if (last && has_next) S.a_ready(nxt);
            if constexpr (SP2) {
            PG8_LDB(B0, 0, 0); PG8_LDB(B1, 0, 1); PG8_SCHED; PG8_LDA(At, 0, 0); PG8_STAGE(PG8_SA(1, 1), a1 + hstep, voffA);
            PG8_WAIT_V(8); PG8_WAIT_L(0); PG8_BAR; PG8_MMA(0, 0, At, B0); PG8_MMA(0, 1, At, B1); PG8_BAR; PG8_SCHED;
            PG8_LDA(At, 0, 1); PG8_STAGE(PG8_SB(0, 0), b2, voffB); PG8_STAGE(PG8_SB(0, 1), b2 + hstep, voffB); PG8_STAGE(PG8_SA(0, 0), a2, voffA);
            PG8_WAIT_V(8); PG8_WAIT_L(0); PG8_BAR; PG8_MMA(1, 0, At, B0); PG8_MMA(1, 1, At, B1); PG8_BAR; PG8_SCHED;
            PG8_LDB(B0, 1, 0); PG8_LDB(B1, 1, 1); PG8_SCHED; PG8_LDA(At, 1, 0); PG8_STAGE(PG8_SA(0, 1), a2 + hstep, voffA);
            PG8_WAIT_V(8); PG8_WAIT_L(0); PG8_BAR; PG8_MMA(0, 0, At, B0); PG8_MMA(0, 1, At, B1); PG8_BAR; PG8_SCHED;
            PG8_LDA(At, 1, 1); PG8_STAGE(PG8_SB(1, 0), b3, voffB); PG8_STAGE(PG8_SB(1, 1), b3 + hstep, voffB); PG8_STAGE(PG8_SA(1, 0), a3, voffA);
            PG8_WAIT_V(8); PG8_WAIT_L(0); PG8_BAR; PG8_MMA(1, 0, At, B0); PG8_MMA(1, 1, At, B1); PG8_BAR; PG8_SCHED;
            } else {
            PG8_LDB(B0, 0, 0); PG8_SCHED; PG8_LDA(At, 0, 0); PG8_STAGE(PG8_SA(1, 1), a1 + hstep, voffA);
            PG8_WAIT_L(8); PG8_BAR; PG8_WAIT_L(0); PG8_MMA(0, 0, At, B0); PG8_BAR; PG8_SCHED;
            PG8_LDB(B1, 0, 1); PG8_STAGE(PG8_SB(0, 0), b2, voffB);
            PG8_BAR; PG8_WAIT_L(0); PG8_MMA(0, 1, At, B1); PG8_BAR;
            PG8_LDA(At, 0, 1); PG8_STAGE(PG8_SA(0, 0), a2, voffA);
            PG8_BAR; PG8_WAIT_L(0); PG8_MMA(1, 0, At, B0); PG8_BAR; PG8_SCHED;
            PG8_STAGE(PG8_SB(0, 1), b2 + hstep, voffB);
            PG8_WAIT_V(6); PG8_BAR; PG8_MMA(1, 1, At, B1); PG8_BAR;
            PG8_LDB(B0, 1, 0); PG8_SCHED; PG8_LDA(At, 1, 0); PG8_STAGE(PG8_SA(0, 1), a2 + hstep, voffA);
            PG8_WAIT_L(8); PG8_BAR; PG8_WAIT_L(0); PG8_MMA(0, 0, At, B0); PG8_BAR; PG8_SCHED;
            PG8_LDB(B1, 1, 1); PG8_STAGE(PG8_SB(1, 0), b3, voffB);
            PG8_BAR; PG8_WAIT_L(0); PG8_MMA(0, 1, At, B1); PG8_BAR;
            PG8_LDA(At, 1, 1); PG8_STAGE(PG8_SA(1, 0), a3, voffA);
            PG8_BAR; PG8_WAIT_L(0); PG8_MMA(1, 0, At, B0); PG8_BAR; PG8_SCHED;
            PG8_STAGE(PG8_SB(1, 1), b3 + hstep, voffB);
            PG8_WAIT_V(6); PG8_BAR; PG8_MMA(1, 1, At, B1); PG8_BAR;
            }
        }
        if constexpr (ALIGN_EPI) { if (wr == 0) PG8_BAR; }
        if constexpr (!Epi::AFTER_DRAIN) { E(acc, est, cur, wr, wc, fr, fq); S.done(cur); }
        if (!has_next) break;
        E.init(acc, est, nxt, wr, wc, fr, fq);
        cur = nxt; cA = nA; cB = nB; ++ui;
        if constexpr (ALIGN_EPI) { if (wr == 1) PG8_BAR; }
    }
    PG8_WAIT_V(0);
    if constexpr (!ALIGN_EPI) { if (wr == 0) PG8_BAR; }
    PG8_BAR;
    if constexpr (Epi::AFTER_DRAIN) { E.fused(acc, cur, wr, wc, fr, fq, lds, wid, lane); S.done(cur); }
#undef PG8_SA
#undef PG8_SB
#undef PG8_STAGE
#undef PG8_LDA
#undef PG8_LDB
#undef PG8_MMA
#undef PG8_WAIT_V
#undef PG8_WAIT_L
#undef PG8_BAR
#undef PG8_SCHED
}
}
#define GAS __attribute__((address_space(1)))
#define LAS __attribute__((address_space(3)))
typedef unsigned short bf16;
typedef unsigned v4u __attribute__((ext_vector_type(4)));
typedef float f32x4 __attribute__((ext_vector_type(4)));
typedef short bf16x8 __attribute__((ext_vector_type(8)));
typedef GAS unsigned gu32;
typedef GAS unsigned long long gu64;
#define RLX_AGENT __ATOMIC_RELAXED, __HIP_MEMORY_SCOPE_AGENT
#define LDS_WAIT() asm volatile("s_waitcnt lgkmcnt(0)" ::: "memory")
#define VM_WAIT() asm volatile("s_waitcnt vmcnt(0)" ::: "memory")
__device__ __forceinline__ unsigned long long rt() { return __builtin_amdgcn_s_memrealtime(); }
__device__ __forceinline__ unsigned f2bf(float f) { unsigned u = __builtin_bit_cast(unsigned, f); return (u + 0x7fffu + ((u >> 16) & 1u)) >> 16; }
__device__ __forceinline__ unsigned pk2(float lo, float hi) { return pg8::cvt_pk_bf16(lo, hi); }

#define XB_TMO      128
#define XB_XCNT(j)  (256  + 64 * (j))
#define XB_XSUB(j)  (1280 + 64 * (j))
#define XB_XGEN(j)  (2304 + 64 * (j))
#define XB_TOP      3328
#define XB_TOPGEN   3392
#define XCD_BAR_WORDS 3456
#define XB_SPIN_CAP (1u << 18)

__device__ __forceinline__ unsigned xb_ld(unsigned* p)              { return __hip_atomic_load(p, __ATOMIC_RELAXED, __HIP_MEMORY_SCOPE_AGENT); }
__device__ __forceinline__ unsigned xb_add(unsigned* p, unsigned v) { return __hip_atomic_fetch_add(p, v, __ATOMIC_RELAXED, __HIP_MEMORY_SCOPE_AGENT); }
__device__ __forceinline__ unsigned xb_xcc_id() { return (unsigned)__builtin_amdgcn_s_getreg((3 << 11) | 20) & 0xFu; }
#define XB_SPIN(cond, bar) do { unsigned _sp = 0; while (cond) { __builtin_amdgcn_s_sleep(1); \
    if ((++_sp & 255u) == 0u) { if (xb_ld(&(bar)[XB_TMO])) break; if (_sp > XB_SPIN_CAP) { atomicAdd(&(bar)[XB_TMO], 1u); break; } } } } while (0)

struct XcdBarrier {
    unsigned* bar; unsigned x;
    int w;
    volatile LAS unsigned* st;
};

__device__ __forceinline__ XcdBarrier xcd_barrier_post(unsigned* bar, volatile LAS unsigned* st) {
    XcdBarrier b; b.bar = bar; b.x = xb_xcc_id(); b.st = st; b.w = __builtin_amdgcn_readfirstlane((int)threadIdx.x >> 6);
    if (threadIdx.x == 0) (void)xb_add(&bar[XB_XCNT(b.x)], 1u);
    return b;
}
__device__ __forceinline__ void xcd_barrier_complete(unsigned* bar, unsigned x, unsigned& nloc, unsigned& nx) {
    const unsigned G = gridDim.x * gridDim.y * gridDim.z;
    unsigned sum, cnt, mine, sp = 0u;
    for (;;) {
        sum = 0u; cnt = 0u; mine = 0u;
#pragma unroll
        for (unsigned j = 0; j < 16; ++j) { const unsigned c = xb_ld(&bar[XB_XCNT(j)]); sum += c; cnt += (c > 0u) ? 1u : 0u; mine = (j == x) ? c : mine; }
        if (sum == G) break;
        __builtin_amdgcn_s_sleep(1);
        if ((++sp & 255u) == 0u) { if (xb_ld(&bar[XB_TMO])) break; if (sp > XB_SPIN_CAP) { atomicAdd(&bar[XB_TMO], 1u); break; } }
    }
    nloc = mine > 0u ? mine : 1u; nx = cnt > 0u ? cnt : 1u;
}

__device__ __forceinline__ void xcd_barrier(const XcdBarrier& b) {
    asm volatile("s_waitcnt vmcnt(0)" ::: "memory");
    __syncthreads();
    if (b.w == 0 && pg8::lane_id_fresh() == 0) {
        unsigned* bar = b.bar;
        __builtin_amdgcn_s_waitcnt(0);
        unsigned nloc = b.st[0], nx = b.st[1];
        if (nloc == 0u) { xcd_barrier_complete(bar, b.x, nloc, nx); b.st[0] = nloc; b.st[1] = nx; }
        const unsigned old = xb_add(&bar[XB_XSUB(b.x)], 1u);
        const unsigned gen = old / nloc;
        if (old + 1u == (gen + 1u) * nloc) {
            __builtin_amdgcn_fence(__ATOMIC_RELEASE, "agent");
            asm volatile("s_waitcnt vmcnt(0)" ::: "memory");
            const unsigned og = xb_add(&bar[XB_TOP], 1u);
            const unsigned tg = og / nx;
            if (og + 1u == (tg + 1u) * nx) xb_add(&bar[XB_TOPGEN], 1u);
            else XB_SPIN(xb_ld(&bar[XB_TOPGEN]) == tg, bar);
            __builtin_amdgcn_fence(__ATOMIC_ACQUIRE, "agent");
            xb_add(&bar[XB_XGEN(b.x)], 1u);
            asm volatile("s_waitcnt vmcnt(0)" ::: "memory");
        } else {
            XB_SPIN(xb_ld(&bar[XB_XGEN(b.x)]) == gen, bar);
            __builtin_amdgcn_fence(__ATOMIC_ACQUIRE, "agent");
            asm volatile("s_waitcnt vmcnt(0)" ::: "memory");
        }
    }
    __syncthreads();
}

constexpr int NWAVES = 8;
constexpr int BATCH = 8, SEQ = 2048, M = BATCH * SEQ, DEPTH = 4;
constexpr int DM = pg8::DM, DFF = pg8::DFF, NUP = 2 * DFF, INW = pg8::INW;
constexpr int AW = 512, HW = 1024;
using pg8::ZC_QA; using pg8::ZC_KA; using pg8::ZC_VA; using pg8::ZC_QH; using pg8::ZC_FH; using pg8::ZC_IH; using pg8::ZC_GH;
constexpr float RMS_EPS = 1e-6f;
#ifndef MK_ONE_LAUNCH
#define MK_ONE_LAUNCH 1
#endif
constexpr int N_PHASES = 1 + 8 * 2 + 4 * 5 + 1;

constexpr size_t MiB = 1u << 20;
constexpr size_t WS_CTL = 0, CTL_ZERO_BYTES = 4 * MiB;
constexpr size_t WS_ROWSS = 2 * MiB;
constexpr size_t WS_LB = 4 * MiB;
constexpr size_t WS_X = 16 * MiB;
constexpr size_t WS_XB = 144 * MiB;
constexpr size_t WS_HFF = 208 * MiB;
constexpr size_t WS_Z = 384 * MiB;
constexpr size_t WS_LOGF = 784 * MiB;
constexpr size_t WS_ATT = 848 * MiB;
constexpr size_t WS_HG = 864 * MiB;
constexpr size_t WS_Y32 = 896 * MiB;
constexpr size_t WS_YB = 1024 * MiB;
constexpr size_t WS_O32 = 1088 * MiB;
constexpr size_t WS_AO = 1152 * MiB;
constexpr size_t WS_LSE = 1200 * MiB;
constexpr size_t WS_SLOC = 1216 * MiB;
constexpr size_t WS_DTOT = 1249 * MiB;
constexpr size_t WS_W = 1300 * MiB;
constexpr size_t WL_BYTES = 193 * MiB;
constexpr size_t WO_W1 = 0, W1_BYTES = 43 * MiB, WO_W2 = 86 * MiB, W2_BYTES = (size_t)DM * DFF * 2, WO_WIN = 129 * MiB, WO_WPA = 179 * MiB, WO_WPM = 181 * MiB, WO_WO = 185 * MiB;
constexpr size_t WS_END = WS_W + 4 * WL_BYTES;
static_assert((size_t)NUP * DM * 2 == W1_BYTES && 2 * W2_BYTES == 43 * MiB && (size_t)INW * DM * 2 == 50 * MiB, "weight map");
static_assert(WS_HFF + (size_t)M * DFF * 2 <= WS_Z && WS_Z + (size_t)M * INW * 2 <= WS_LOGF, "ws map");
constexpr int CW_BAR = 4096;

constexpr int RING_OFF = 0, RING_BYTES = 131072;
constexpr int LDS_BYTES = 159744;
constexpr int LDSCTL_OFF = LDS_BYTES - 512, MISC_OFF = LDSCTL_OFF + 320;
static_assert(MISC_OFF + 128 <= LDS_BYTES, "LDS map");

__device__ __forceinline__ float wave_sum(float v) {
#pragma unroll
    for (int o = 1; o < 64; o <<= 1) v += __shfl_xor(v, o);
    return v;
}
using pg8::bflo; using pg8::bfhi; using pg8::lane_id_fresh;
typedef float f32x2 __attribute__((ext_vector_type(2)));
using pg8::u32x2;

__device__ __forceinline__ void tr_item(const float* __restrict__ W, int K, int N, bf16* __restrict__ WT, const float* __restrict__ gain, bool ilv, LAS float* scr, int item, int lane) {
    const int nblk = N >> 5, kb = item / nblk, nb = item - kb * nblk, k0 = kb << 6, n0 = nb << 5;
    const int lr = lane >> 3, c4 = (lane & 7) << 2;
#pragma unroll
    for (int i = 0; i < 8; ++i) {
        const int kk = 8 * i + lr;
        const f32x4 v = *(const GAS f32x4*)(W + (size_t)(k0 + kk) * N + n0 + c4);
        const float g = gain ? gain[k0 + kk] : 1.0f;
        LAS float* d = scr + kk * 33 + c4;
        d[0] = v.x * g; d[1] = v.y * g; d[2] = v.z * g; d[3] = v.w * g;
    }
    LDS_WAIT(); asm volatile("" ::: "memory");
    const int c = lane & 7;
#pragma unroll
    for (int j = 0; j < 4; ++j) {
        const int n = (lane >> 3) + 8 * j; const LAS float* s = scr + (8 * c) * 33 + n;
        v4u o; o.x = pk2(s[0 * 33], s[1 * 33]); o.y = pk2(s[2 * 33], s[3 * 33]); o.z = pk2(s[4 * 33], s[5 * 33]); o.w = pk2(s[6 * 33], s[7 * 33]);
        const int col = n0 + n; int drow = col;
        if (ilv) { const int up = col >= DFF ? 1 : 0; const int jj = up ? col - DFF : col; drow = ((jj >> 7) << 8) + (up << 7) + (jj & 127); }
        *(GAS v4u*)(WT + (size_t)drow * K + k0 + 8 * c) = o;
    }
    LDS_WAIT(); asm volatile("" ::: "memory");
}

struct Args { const float* in[13]; float* out; unsigned char* ws; int ph_lo, ph_hi; };
constexpr int I_W1 = (DM / 64) * (NUP / 32), I_W2 = (DFF / 64) * (DM / 32), I_WIN = (DM / 64) * (INW / 32), I_WPA = (AW / 64) * (DM / 32), I_WPM = (HW / 64) * (DM / 32), I_WO = (DM / 64) * (DM / 32);
constexpr int I_LAYER = 2 * I_W1 + 2 * I_W2 + I_WIN + I_WPA + I_WPM + I_WO;
struct ConvSrc { const float *ffn_norm, *ffn_w_in, *ffn_w_out, *mix_norm, *w_in, *w_pa, *w_pm, *w_o; unsigned char* ws; };
__device__ __forceinline__ ConvSrc conv_src() {
    const __attribute__((address_space(4))) Args* ka = (const __attribute__((address_space(4))) Args*)__builtin_amdgcn_kernarg_segment_ptr();
    asm volatile("" : "+s"(ka));
    return ConvSrc{ka->in[1], ka->in[2], ka->in[3], ka->in[4], ka->in[5], ka->in[9], ka->in[10], ka->in[11], ka->ws};
}
__device__ __forceinline__ void conv_item(const ConvSrc& C, int it, LAS float* scr, int lane) {
    const int l = it / I_LAYER; int r = it - l * I_LAYER;
    unsigned char* wl = C.ws + WS_W + (size_t)l * WL_BYTES;
    if (r < 2 * I_W1) { const int s = r >= I_W1 ? 1 : 0; r -= s * I_W1;
        tr_item(C.ffn_w_in + (size_t)(l * 2 + s) * DM * NUP, DM, NUP, (bf16*)(wl + WO_W1 + s * W1_BYTES), C.ffn_norm + (size_t)(l * 2 + s) * DM, true, scr, r, lane); return; }
    r -= 2 * I_W1;
    if (r < 2 * I_W2) { const int s = r >= I_W2 ? 1 : 0; r -= s * I_W2;
        tr_item(C.ffn_w_out + (size_t)(l * 2 + s) * DFF * DM, DFF, DM, (bf16*)(wl + WO_W2 + s * W2_BYTES), nullptr, false, scr, r, lane); return; }
    r -= 2 * I_W2;
    if (r < I_WIN) { tr_item(C.w_in + (size_t)l * DM * INW, DM, INW, (bf16*)(wl + WO_WIN), C.mix_norm + (size_t)l * DM, false, scr, r, lane); return; }
    r -= I_WIN;
    if (r < I_WPA) { tr_item(C.w_pa + (size_t)l * AW * DM, AW, DM, (bf16*)(wl + WO_WPA), nullptr, false, scr, r, lane); return; }
    r -= I_WPA;
    if (r < I_WPM) { tr_item(C.w_pm + (size_t)l * HW * DM, HW, DM, (bf16*)(wl + WO_WPM), nullptr, false, scr, r, lane); return; }
    r -= I_WPM;
    tr_item(C.w_o + (size_t)l * DM * DM, DM, DM, (bf16*)(wl + WO_WO), nullptr, false, scr, r, lane);
}
constexpr int AT_KSTR = 272, AT_VSTR = 528, AT_K_OFF = 0, AT_V_OFF = 256 * AT_KSTR;
static_assert(AT_V_OFF + 128 * AT_VSTR <= LDSCTL_OFF, "attention LDS");
#define AT_BAR() do { asm volatile("s_waitcnt lgkmcnt(0)" ::: "memory"); __builtin_amdgcn_s_barrier(); asm volatile("" ::: "memory"); } while (0)
__device__ __forceinline__ void attn_fast(LAS unsigned char* lds, const bf16* __restrict__ QKV, bf16* __restrict__ AO, float* __restrict__ LSE, int bx, int G, int w) {
    const int lane = lane_id_fresh(), tid = w * 64 + lane, fr = lane & 15, fq = lane >> 4;
    for (int idx = bx; idx < 1536; idx += G) {
        const int g = idx >> 9, rem = idx & 511, b = rem >> 6, h = (rem >> 4) & 3, blk = rem & 15;
        const int sh = 2 * g, nb = 16 >> sh, c = blk >> (4 - sh), n = blk & (nb - 1);
        const int j0 = n > 0 ? 0 : 128;
        const size_t zb = (size_t)b * SEQ;
        const size_t sb = ((size_t)((b * 3 + g) * 4 + h) * SEQ + (size_t)c * (SEQ >> sh)) * 128;
        const bf16* QA = QKV + sb; const bf16* KA = QKV + pg8::QKV_PART + sb; const bf16* VA = QKV + 2 * pg8::QKV_PART + sb;
        const int qi = 16 * w + fr; const size_t qrow = zb + ((size_t)(128 * n + qi) << sh) + c;
        bf16x8 qf[4];
#pragma unroll
        for (int ks = 0; ks < 4; ++ks) qf[ks] = *(const GAS bf16x8*)(QA + (size_t)(128 * n + qi) * 128 + 32 * ks + 8 * fq);
        if (n == 0) {
#pragma unroll
            for (int it = 0; it < 4; ++it) { const int ch = tid + 512 * it, d = ch >> 4, cc = ch & 15; *(LAS v4u*)(lds + AT_V_OFF + d * AT_VSTR + cc * 16) = (v4u){0u, 0u, 0u, 0u}; }
        }
#pragma unroll
        for (int it = 0; it < 8; ++it) {
            const int ch = tid + 512 * it, j = ch >> 4, dc = ch & 15;
            if (j >= j0) {
                const size_t go = (size_t)(128 * (n - 1) + j) * 128 + 8 * dc;
                const v4u kw = *(const GAS v4u*)(KA + go);
                const v4u vw = *(const GAS v4u*)(VA + go);
                *(LAS v4u*)(lds + AT_K_OFF + j * AT_KSTR + dc * 16) = kw;
                LAS unsigned short* vt = (LAS unsigned short*)(lds + AT_V_OFF + (8 * dc) * AT_VSTR) + (j ^ (dc << 2));
                vt[0 * (AT_VSTR / 2)] = (unsigned short)(vw.x & 0xffffu); vt[1 * (AT_VSTR / 2)] = (unsigned short)(vw.x >> 16);
                vt[2 * (AT_VSTR / 2)] = (unsigned short)(vw.y & 0xffffu); vt[3 * (AT_VSTR / 2)] = (unsigned short)(vw.y >> 16);
                vt[4 * (AT_VSTR / 2)] = (unsigned short)(vw.z & 0xffffu); vt[5 * (AT_VSTR / 2)] = (unsigned short)(vw.z >> 16);
                vt[6 * (AT_VSTR / 2)] = (unsigned short)(vw.w & 0xffffu); vt[7 * (AT_VSTR / 2)] = (unsigned short)(vw.w >> 16);
            }
        }
        AT_BAR();
        const int tl0 = n > 0 ? 0 : 8 - w;
        f32x4 st[9];
#pragma unroll
        for (int tl = 0; tl < 9; ++tl) {
            st[tl] = (f32x4){0.f, 0.f, 0.f, 0.f};
            if (tl >= tl0) {
                const int kt = w + tl;
#pragma unroll
                for (int ks = 0; ks < 4; ++ks) { const bf16x8 a = *(const LAS bf16x8*)(lds + AT_K_OFF + (16 * kt + fr) * AT_KSTR + (32 * ks + 8 * fq) * 2); st[tl] = __builtin_amdgcn_mfma_f32_16x16x32_bf16(a, qf[ks], st[tl], 0, 0, 0); }
            }
        }
        float mx = -1e30f;
#pragma unroll
        for (int tl = 0; tl < 9; ++tl)
#pragma unroll
            for (int i = 0; i < 4; ++i) { const int dlt = 16 * tl + 4 * fq + i - fr; const bool valid = (dlt >= 0) && (dlt <= 128) && (tl >= tl0); const float sv = valid ? st[tl][i] : -1e30f; st[tl][i] = sv; mx = fmaxf(mx, sv); }
        mx = fmaxf(mx, __shfl_xor(mx, 16)); mx = fmaxf(mx, __shfl_xor(mx, 32));
        float l = 0.f;
#pragma unroll
        for (int tl = 0; tl < 9; ++tl)
#pragma unroll
            for (int i = 0; i < 4; ++i) { const float pv = __builtin_amdgcn_exp2f(st[tl][i] - mx); st[tl][i] = pv; l += pv; }
        l += __shfl_xor(l, 16); l += __shfl_xor(l, 32);
        f32x4 o[8];
#pragma unroll
        for (int dt = 0; dt < 8; ++dt) o[dt] = (f32x4){0.f, 0.f, 0.f, 0.f};
#pragma unroll
        for (int p = 0; p < 5; ++p) {
            if (2 * p + 1 >= tl0) {
                v4u pw; pw.x = pk2(st[2 * p][0], st[2 * p][1]); pw.y = pk2(st[2 * p][2], st[2 * p][3]);
                if (p < 4) { pw.z = pk2(st[(2 * p + 1) % 9][0], st[(2 * p + 1) % 9][1]); pw.w = pk2(st[(2 * p + 1) % 9][2], st[(2 * p + 1) % 9][3]); } else { pw.z = 0u; pw.w = 0u; }
                const bf16x8 pb = __builtin_bit_cast(bf16x8, pw);
                const int kta = w + 2 * p, ktb = (w + 2 * p + 1) < 15 ? (w + 2 * p + 1) : 15;
#pragma unroll
                for (int dt = 0; dt < 8; ++dt) {
                    const int d = 16 * dt + fr, swz = (2 * dt + (fr >> 3)) << 2;
                    const u32x2 lo = *(const LAS u32x2*)(lds + AT_V_OFF + d * AT_VSTR + 2 * ((16 * kta + 4 * fq) ^ swz));
                    const u32x2 hi = *(const LAS u32x2*)(lds + AT_V_OFF + d * AT_VSTR + 2 * ((16 * ktb + 4 * fq) ^ swz));
                    const bf16x8 va = __builtin_bit_cast(bf16x8, (v4u){lo.x, lo.y, hi.x, hi.y});
                    o[dt] = __builtin_amdgcn_mfma_f32_16x16x32_bf16(va, pb, o[dt], 0, 0, 0);
                }
            }
        }
        const float inv = 1.0f / l;
        bf16* orow = AO + ((size_t)g * M + qrow) * AW + h * 128 + 4 * fq;
#pragma unroll
        for (int dt = 0; dt < 8; ++dt) { u32x2 ov; ov.x = pk2(o[dt][0] * inv, o[dt][1] * inv); ov.y = pk2(o[dt][2] * inv, o[dt][3] * inv); *(GAS u32x2*)(orow + 16 * dt) = ov; }
        if (fq == 0) LSE[((size_t)g * M + qrow) * 4 + h] = mx + __builtin_amdgcn_logf(l);
        AT_BAR();
    }
}
__device__ __forceinline__ void attn_combine(const bf16* __restrict__ AO, const float* __restrict__ LSE, bf16* __restrict__ ATT, int gw, int NGW) {
    const int lane = lane_id_fresh();
    for (int idx = gw * 64 + lane; idx < M * 64; idx += NGW * 64) {
        const int row = idx >> 6, h = (idx >> 4) & 3, dc = idx & 15;
        const float l0 = LSE[(size_t)row * 4 + h], l1 = LSE[((size_t)M + row) * 4 + h], l2 = LSE[((size_t)2 * M + row) * 4 + h];
        const float mx = fmaxf(l0, fmaxf(l1, l2));
        float w0 = __builtin_amdgcn_exp2f(l0 - mx), w1 = __builtin_amdgcn_exp2f(l1 - mx), w2 = __builtin_amdgcn_exp2f(l2 - mx);
        const float inv = 1.0f / (w0 + w1 + w2); w0 *= inv; w1 *= inv; w2 *= inv;
        const size_t off = (size_t)row * AW + h * 128 + 8 * dc;
        const v4u a = *(const GAS v4u*)(AO + off), b = *(const GAS v4u*)(AO + (size_t)M * AW + off), c = *(const GAS v4u*)(AO + (size_t)2 * M * AW + off);
        v4u r;
        r.x = pk2(w0 * bflo(a.x) + w1 * bflo(b.x) + w2 * bflo(c.x), w0 * bfhi(a.x) + w1 * bfhi(b.x) + w2 * bfhi(c.x));
        r.y = pk2(w0 * bflo(a.y) + w1 * bflo(b.y) + w2 * bflo(c.y), w0 * bfhi(a.y) + w1 * bfhi(b.y) + w2 * bfhi(c.y));
        r.z = pk2(w0 * bflo(a.z) + w1 * bflo(b.z) + w2 * bflo(c.z), w0 * bfhi(a.z) + w1 * bfhi(b.z) + w2 * bfhi(c.z));
        r.w = pk2(w0 * bflo(a.w) + w1 * bflo(b.w) + w2 * bflo(c.w), w0 * bfhi(a.w) + w1 * bfhi(b.w) + w2 * bfhi(c.w));
        *(GAS v4u*)(ATT + off) = r;
    }
}

constexpr int HB_STR = 132 * 4, HQ_STR = 264, HQT_STR = 272, HKB_STR = 144, HP_STR = 40;
constexpr int HB_OFF = 0, HQ_OFF = HB_OFF + 64 * HB_STR, HK_OFF = HQ_OFF + 64 * HQ_STR, HQT_OFF = HK_OFF + 64 * HQ_STR, HKB_OFF = HQT_OFF + 64 * HQT_STR, HVT_OFF = HKB_OFF + 128 * HKB_STR,
              HP_OFF = HVT_OFF + 128 * HKB_STR, HD_OFF = HP_OFF + 64 * HP_STR, HBL_OFF = HD_OFF + 2048, HFLAG_OFF = HBL_OFF + 2048, H_END = HFLAG_OFF + 16,
              HQP_OFF = HB_OFF, HKP_OFF = HB_OFF + 64 * HQ_STR;
#ifndef HG_EXPMAX
#define HG_EXPMAX 100.0f
#endif
static_assert(HKP_OFF + 64 * HQ_STR <= HQ_OFF, "fast-path images inside the b image");
static_assert(H_END <= LDSCTL_OFF && HQ_OFF % 16 == 0 && HK_OFF % 16 == 0 && HQT_OFF % 16 == 0 && HKB_OFF % 16 == 0 && HVT_OFF % 16 == 0 && HP_OFF % 16 == 0 && HD_OFF % 16 == 0, "hgrn LDS");
typedef short s16x4 __attribute__((ext_vector_type(4)));
#define HG_BAR() do { asm volatile("s_waitcnt lgkmcnt(0)" ::: "memory"); __builtin_amdgcn_s_barrier(); asm volatile("" ::: "memory"); } while (0)
template <bool FULL>
__device__ __forceinline__ void hgrn_pass(LAS unsigned char* lds, const bf16* __restrict__ HBF, const float* __restrict__ LOGF, const float* __restrict__ hnorm, float* __restrict__ SLOC, float* __restrict__ DTOT,
                                          bf16* __restrict__ HG, int bx, int G, int w) {
    const int lane = lane_id_fresh(), tid = w * 64 + lane, fr = lane & 15, fq = lane >> 4;
    const int J1 = tid >> 7, k1 = tid & 127;
    constexpr int NITEM = FULL ? 512 : 448;
    for (int idx = bx; idx < NITEM; idx += G) {
        const int bh = FULL ? (idx >> 3) : (idx / 7), sc = FULL ? ((idx & 256) ? 7 - (idx & 7) : (idx & 7)) : (idx - 7 * (idx / 7)), b = bh >> 3, h = bh & 7;
        const size_t row0 = (size_t)bh * SEQ + (size_t)sc * 256;
        const bf16* HQ = HBF; const bf16* HKEY = HBF + pg8::HB_PART; const bf16* HI = HBF + 2 * pg8::HB_PART; const bf16* HGT = HBF + 3 * pg8::HB_PART;
        f32x4 S[8];
#pragma unroll
        for (int kt = 0; kt < 8; ++kt) S[kt] = (f32x4){0.f, 0.f, 0.f, 0.f};
        if (FULL) {
            for (int m = 0; m < sc; ++m) {
                const float* dt = DTOT + (size_t)(bh * 8 + m) * 128; const float* sl = SLOC + ((size_t)(bh * 8 + m) * 64 + w * 8) * 256 + lane * 4;
#pragma unroll
                for (int kt = 0; kt < 8; ++kt) { const f32x4 dv = *(const GAS f32x4*)(dt + 16 * kt + 4 * fq); const f32x4 sv = *(const GAS f32x4*)(sl + kt * 256); S[kt] = S[kt] * dv + sv; }
            }
        }
        if (FULL) { if (tid == 0) *(LAS unsigned*)(lds + HFLAG_OFF) = 0u; HG_BAR(); }
        float dsum = 0.f;
        float lf[16]; unsigned kr[16], vr[16], qr[16];
#define HG_LOAD(chn) do { const size_t rJ_ = row0 + 64 * (chn) + 16 * J1; \
        _Pragma("unroll") for (int t = 0; t < 16; ++t) { lf[t] = LOGF[(rJ_ + t) * 128 + k1]; kr[t] = *(const GAS unsigned short*)(HKEY + (rJ_ + t) * 128 + k1); vr[t] = *(const GAS unsigned short*)(HI + (rJ_ + t) * 128 + k1); \
            if (FULL) qr[t] = *(const GAS unsigned short*)(HQ + (rJ_ + t) * 128 + k1); } } while (0)
        HG_LOAD(0);
#pragma unroll 1
        for (int ch = 0; ch < 4; ++ch) {
            const size_t crow0 = row0 + 64 * ch;
            {
                float bb[16]; float run = 0.f;
#pragma unroll
                for (int t = 0; t < 16; ++t) { run += lf[t]; bb[t] = run; }
                unsigned kbw[8], ivw[8];
#pragma unroll
                for (int t = 0; t < 16; t += 2) {
                    const float kfa = __uint_as_float(kr[t] << 16), kfb = __uint_as_float(kr[t + 1] << 16);
                    kbw[t >> 1] = pk2(kfa * __builtin_amdgcn_exp2f(run - bb[t]), kfb * __builtin_amdgcn_exp2f(run - bb[t + 1]));
                    ivw[t >> 1] = vr[t] | (vr[t + 1] << 16);
                    if (FULL) {
                        const float qfa = __uint_as_float(qr[t] << 16), qfb = __uint_as_float(qr[t + 1] << 16);
                        const int ta = 16 * J1 + t;
                        const unsigned qpw = pk2(qfa * __builtin_amdgcn_exp2f(bb[t] - bb[7]), qfb * __builtin_amdgcn_exp2f(bb[t + 1] - bb[7]));
                        const unsigned kpw = pk2(kfa * __builtin_amdgcn_exp2f(bb[7] - bb[t]), kfb * __builtin_amdgcn_exp2f(bb[7] - bb[t + 1]));
                        *(LAS unsigned short*)(lds + HQP_OFF + ta * HQ_STR + k1 * 2) = (unsigned short)(qpw & 0xffffu); *(LAS unsigned short*)(lds + HQP_OFF + (ta + 1) * HQ_STR + k1 * 2) = (unsigned short)(qpw >> 16);
                        *(LAS unsigned short*)(lds + HKP_OFF + ta * HQ_STR + k1 * 2) = (unsigned short)(kpw & 0xffffu); *(LAS unsigned short*)(lds + HKP_OFF + (ta + 1) * HQ_STR + k1 * 2) = (unsigned short)(kpw >> 16);
                        const unsigned qtw = pk2(qfa * __builtin_amdgcn_exp2f(bb[t]), qfb * __builtin_amdgcn_exp2f(bb[t + 1]));
                        *(LAS unsigned short*)(lds + HQT_OFF + ta * HQT_STR + k1 * 2) = (unsigned short)(qtw & 0xffffu);
                        *(LAS unsigned short*)(lds + HQT_OFF + (ta + 1) * HQT_STR + k1 * 2) = (unsigned short)(qtw >> 16);
                    }
                }
                if (FULL && ((-bb[7] > HG_EXPMAX) || (bb[7] - run > HG_EXPMAX))) *(LAS unsigned*)(lds + HFLAG_OFF) = 1u;
                *(LAS v4u*)(lds + HKB_OFF + k1 * HKB_STR + J1 * 32) = (v4u){kbw[0], kbw[1], kbw[2], kbw[3]}; *(LAS v4u*)(lds + HKB_OFF + k1 * HKB_STR + J1 * 32 + 16) = (v4u){kbw[4], kbw[5], kbw[6], kbw[7]};
                *(LAS v4u*)(lds + HVT_OFF + k1 * HKB_STR + J1 * 32) = (v4u){ivw[0], ivw[1], ivw[2], ivw[3]}; *(LAS v4u*)(lds + HVT_OFF + k1 * HKB_STR + J1 * 32 + 16) = (v4u){ivw[4], ivw[5], ivw[6], ivw[7]};
                *(LAS float*)(lds + HD_OFF + (J1 * 128 + k1) * 4) = __builtin_amdgcn_exp2f(run);
                if (!FULL) *(LAS float*)(lds + HBL_OFF + (J1 * 128 + k1) * 4) = run;
                if (FULL && tid < 160) *(LAS v4u*)(lds + HP_OFF + tid * 16) = (v4u){0u, 0u, 0u, 0u};
            }
            if (ch < 3) HG_LOAD(ch + 1);
            v4u g0, g1;
            if (FULL) { const bf16* gp = HGT + (crow0 + (tid >> 3)) * 128 + 16 * (tid & 7); g0 = *(const GAS v4u*)gp; g1 = *(const GAS v4u*)(gp + 8); }
            HG_BAR();
            if (FULL) {
                const bool slow = *(const LAS unsigned*)(lds + HFLAG_OFF) != 0u;
                if (!slow) {
                    if (w < 4) {
                        f32x4 pacc = (f32x4){0.f, 0.f, 0.f, 0.f};
#pragma unroll
                        for (int ks = 0; ks < 4; ++ks) {
                            const LAS unsigned char* ra = lds + HQP_OFF + (16 * w + fr) * HQ_STR + (32 * ks + 8 * fq) * 2; const LAS unsigned char* rb = lds + HKP_OFF + (16 * w + fr) * HQ_STR + (32 * ks + 8 * fq) * 2;
                            const u32x2 a0 = *(const LAS u32x2*)ra, a1 = *(const LAS u32x2*)(ra + 8), b0 = *(const LAS u32x2*)rb, b1 = *(const LAS u32x2*)(rb + 8);
                            pacc = __builtin_amdgcn_mfma_f32_16x16x32_bf16(__builtin_bit_cast(bf16x8, (v4u){a0.x, a0.y, a1.x, a1.y}), __builtin_bit_cast(bf16x8, (v4u){b0.x, b0.y, b1.x, b1.y}), pacc, 0, 0, 0);
                        }
#pragma unroll
                        for (int i = 0; i < 4; ++i) { const int t = 4 * fq + i; const float pv = (fr <= t) ? pacc[i] : 0.f; *(LAS unsigned short*)(lds + HP_OFF + (16 * w + t) * HP_STR + fr * 2) = (unsigned short)(pk2(pv, 0.f) & 0xffffu); }
                    }
                } else {
                    {
                        const size_t rJ = crow0 + 16 * J1; float run2 = 0.f;
#pragma unroll
                        for (int t = 0; t < 16; ++t) {
                            run2 += LOGF[(rJ + t) * 128 + k1]; const int ta = 16 * J1 + t;
                            *(LAS float*)(lds + HB_OFF + ta * HB_STR + k1 * 4) = run2;
                            *(LAS unsigned short*)(lds + HQ_OFF + ta * HQ_STR + k1 * 2) = *(const GAS unsigned short*)(HQ + (rJ + t) * 128 + k1);
                            *(LAS unsigned short*)(lds + HK_OFF + ta * HQ_STR + k1 * 2) = *(const GAS unsigned short*)(HKEY + (rJ + t) * 128 + k1);
                        }
                    }
                    HG_BAR();
    #pragma unroll 1
                    for (int rr = 0; rr < 3; ++rr) {
                        const int hp = tid + 512 * rr;
                        if (rr < 2 || w == 0) {
                            const int pr = hp >> 1, half = hp & 1, J = pr / 136, pp = pr - 136 * J;
                            int t = (int)((__builtin_sqrtf(8.0f * (float)pp + 1.0f) - 1.0f) * 0.5f);
                            if ((t + 1) * (t + 2) / 2 <= pp) ++t;
                            if (t * (t + 1) / 2 > pp) --t;
                            const int s2 = pp - t * (t + 1) / 2;
                            const LAS unsigned char* bt = lds + HB_OFF + (16 * J + t) * HB_STR + half * 256; const LAS unsigned char* bs = lds + HB_OFF + (16 * J + s2) * HB_STR + half * 256;
                            const LAS unsigned char* qp = lds + HQ_OFF + (16 * J + t) * HQ_STR + half * 128; const LAS unsigned char* kp = lds + HK_OFF + (16 * J + s2) * HQ_STR + half * 128;
                            float a0 = 0.f, a1 = 0.f;
    #pragma unroll 4
                            for (int kk = 0; kk < 16; ++kk) {
                                const f32x4 b1 = *(const LAS f32x4*)(bt + kk * 16), b2 = *(const LAS f32x4*)(bs + kk * 16);
                                const u32x2 qw = *(const LAS u32x2*)(qp + kk * 8), kw = *(const LAS u32x2*)(kp + kk * 8);
                                a0 += bflo(qw.x) * bflo(kw.x) * __builtin_amdgcn_exp2f(b1[0] - b2[0]); a1 += bfhi(qw.x) * bfhi(kw.x) * __builtin_amdgcn_exp2f(b1[1] - b2[1]);
                                a0 += bflo(qw.y) * bflo(kw.y) * __builtin_amdgcn_exp2f(b1[2] - b2[2]); a1 += bfhi(qw.y) * bfhi(kw.y) * __builtin_amdgcn_exp2f(b1[3] - b2[3]);
                            }
                            float a = a0 + a1; a += __shfl_xor(a, 1);
                            if (half == 0) *(LAS unsigned short*)(lds + HP_OFF + (16 * J + t) * HP_STR + s2 * 2) = (unsigned short)(pk2(a, 0.f) & 0xffffu);
                        }
                    }
                }
                HG_BAR();
                if (tid == 0) *(LAS unsigned*)(lds + HFLAG_OFF) = 0u;
            }
#pragma unroll 1
            for (int J = 0; J < 4; ++J) {
                const s16x4 vb = *(const LAS s16x4*)(lds + HVT_OFF + (16 * w + fr) * HKB_STR + (16 * J + 4 * fq) * 2);
                if (FULL) {
                    f32x4 o = (f32x4){0.f, 0.f, 0.f, 0.f};
#pragma unroll
                    for (int kk = 0; kk < 4; ++kk) {
                        const LAS unsigned char* qr = lds + HQT_OFF + (16 * J + fr) * HQT_STR + (32 * kk + 4 * fq) * 2;
                        const u32x2 lo = *(const LAS u32x2*)qr, hi = *(const LAS u32x2*)(qr + 32);
                        const bf16x8 qa = __builtin_bit_cast(bf16x8, (v4u){lo.x, lo.y, hi.x, hi.y});
                        v4u sw; sw.x = pk2(S[2 * kk][0], S[2 * kk][1]); sw.y = pk2(S[2 * kk][2], S[2 * kk][3]); sw.z = pk2(S[2 * kk + 1][0], S[2 * kk + 1][1]); sw.w = pk2(S[2 * kk + 1][2], S[2 * kk + 1][3]);
                        o = __builtin_amdgcn_mfma_f32_16x16x32_bf16(qa, __builtin_bit_cast(bf16x8, sw), o, 0, 0, 0);
                    }
                    const s16x4 pa = *(const LAS s16x4*)(lds + HP_OFF + (16 * J + fr) * HP_STR + 4 * fq * 2);
                    o = __builtin_amdgcn_mfma_f32_16x16x16bf16_1k(pa, vb, o, 0, 0, 0);
#pragma unroll
                    for (int i = 0; i < 4; ++i) *(LAS float*)(lds + HB_OFF + (16 * J + 4 * fq + i) * HB_STR + (16 * w + fr) * 4) = o[i];
                }
#pragma unroll
                for (int kt = 0; kt < 8; ++kt) {
                    const f32x4 dv = *(const LAS f32x4*)(lds + HD_OFF + (J * 128 + 16 * kt + 4 * fq) * 4);
                    const s16x4 ka = *(const LAS s16x4*)(lds + HKB_OFF + (16 * kt + fr) * HKB_STR + (16 * J + 4 * fq) * 2);
                    S[kt] = __builtin_amdgcn_mfma_f32_16x16x16bf16_1k(ka, vb, S[kt] * dv, 0, 0, 0);
                }
            }
            if (!FULL && tid < 128) dsum += (*(const LAS float*)(lds + HBL_OFF + tid * 4) + *(const LAS float*)(lds + HBL_OFF + (128 + tid) * 4)) + (*(const LAS float*)(lds + HBL_OFF + (256 + tid) * 4) + *(const LAS float*)(lds + HBL_OFF + (384 + tid) * 4));
            HG_BAR();
            if (FULL) {
                const int t = tid >> 3, vg = tid & 7;
                const LAS unsigned char* op = lds + HB_OFF + t * HB_STR + vg * 64;
                f32x4 ov[4]; float ss = 0.f;
#pragma unroll
                for (int q4 = 0; q4 < 4; ++q4) { ov[q4] = *(const LAS f32x4*)(op + q4 * 16); ss += (ov[q4][0] * ov[q4][0] + ov[q4][1] * ov[q4][1]) + (ov[q4][2] * ov[q4][2] + ov[q4][3] * ov[q4][3]); }
                ss += __shfl_xor(ss, 1); ss += __shfl_xor(ss, 2); ss += __shfl_xor(ss, 4);
                const float r = __builtin_amdgcn_rsqf(ss * (1.0f / 128.0f) + RMS_EPS);
                const float* np = hnorm + 16 * vg;
                const f32x4 n0 = *(const GAS f32x4*)np, n1 = *(const GAS f32x4*)(np + 4), n2 = *(const GAS f32x4*)(np + 8), n3 = *(const GAS f32x4*)(np + 12);
                v4u r0, r1;
                r0.x = pk2(ov[0][0] * r * n0[0] * bflo(g0.x), ov[0][1] * r * n0[1] * bfhi(g0.x)); r0.y = pk2(ov[0][2] * r * n0[2] * bflo(g0.y), ov[0][3] * r * n0[3] * bfhi(g0.y));
                r0.z = pk2(ov[1][0] * r * n1[0] * bflo(g0.z), ov[1][1] * r * n1[1] * bfhi(g0.z)); r0.w = pk2(ov[1][2] * r * n1[2] * bflo(g0.w), ov[1][3] * r * n1[3] * bfhi(g0.w));
                r1.x = pk2(ov[2][0] * r * n2[0] * bflo(g1.x), ov[2][1] * r * n2[1] * bfhi(g1.x)); r1.y = pk2(ov[2][2] * r * n2[2] * bflo(g1.y), ov[2][3] * r * n2[3] * bfhi(g1.y));
                r1.z = pk2(ov[3][0] * r * n3[0] * bflo(g1.z), ov[3][1] * r * n3[1] * bfhi(g1.z)); r1.w = pk2(ov[3][2] * r * n3[2] * bflo(g1.w), ov[3][3] * r * n3[3] * bfhi(g1.w));
                bf16* hp2 = HG + ((size_t)b * SEQ + (size_t)sc * 256 + 64 * ch + t) * HW + h * 128 + 16 * vg;
                *(GAS v4u*)hp2 = r0; *(GAS v4u*)(hp2 + 8) = r1;
                HG_BAR();
            }
        }
        if (!FULL) {
            float* sl = SLOC + ((size_t)(bh * 8 + sc) * 64 + w * 8) * 256 + lane * 4;
#pragma unroll
            for (int kt = 0; kt < 8; ++kt) *(GAS f32x4*)(sl + kt * 256) = S[kt];
            if (tid < 128) DTOT[(size_t)(bh * 8 + sc) * 128 + tid] = __builtin_amdgcn_exp2f(dsum);
        }
    }
}
typedef const __attribute__((address_space(4))) Args* KArgs;
__device__ __forceinline__ KArgs kargs() { KArgs ka = (KArgs)__builtin_amdgcn_kernarg_segment_ptr(); asm volatile("" : "+s"(ka)); return ka; }
__global__ void __launch_bounds__(NWAVES * 64, 2) mk_fwd(Args args) {
    extern __shared__ __attribute__((aligned(16))) unsigned char lds_raw[];
    LAS unsigned char* lds = (LAS unsigned char*)lds_raw;
    const int wave = __builtin_amdgcn_readfirstlane((int)threadIdx.x >> 6);
    const int G = gridDim.x; const int bx = blockIdx.x;
    const int vcu = (G % 8 == 0) ? (bx % 8) * (G / 8) + bx / 8 : bx;
    const int gw = vcu * NWAVES + wave, NGW = G * NWAVES;
    for (int u = wave * 64 + lane_id_fresh(); u < (LDS_BYTES - LDSCTL_OFF) / 4; u += NWAVES * 64) ((LAS unsigned*)(lds + LDSCTL_OFF))[u] = 0u;
    __syncthreads();
    const int lo = args.ph_lo, hi = args.ph_hi;
    XcdBarrier bar; bar.bar = (unsigned*)(args.ws + WS_CTL) + CW_BAR; bar.x = 0; bar.st = nullptr; bar.w = wave;
    if (hi - lo > 1) bar = xcd_barrier_post((unsigned*)(args.ws + WS_CTL) + CW_BAR, (volatile LAS unsigned*)(lds + MISC_OFF) + 8);
#define IN(k) (lo <= (k) && (k) < hi)
#define SEAM() do { if (IN(ph) && IN(ph + 1)) xcd_barrier(bar); ++ph; } while (0)
#define WSP(T, off) ((T*)(ws + (off)))
    int ph = 0;

    if (IN(ph)) {
        const KArgs ka = kargs(); unsigned char* ws = ka->ws; const float* x_in = ka->in[0]; const float* hgrn_lb = ka->in[7];
        pg8::ss_t* ROWSS = WSP(pg8::ss_t, WS_ROWSS); float* LB = WSP(float, WS_LB); bf16* XB = WSP(bf16, WS_XB);
        const int lane = lane_id_fresh();
        LAS float* scr = (LAS float*)(lds + RING_OFF + wave * 16384);
        const ConvSrc CS = conv_src();
        for (int it = gw; it < DEPTH * I_LAYER; it += NGW) conv_item(CS, it, scr, lane);
        for (int row = gw; row < M; row += NGW) {
            const GAS f32x4* xr = (const GAS f32x4*)(x_in + (size_t)row * DM) + lane;
            GAS unsigned long long* xb8 = (GAS unsigned long long*)(XB + (size_t)row * DM) + lane;
            f32x4 v[8]; float s = 0.f;
#pragma unroll
            for (int j = 0; j < 8; ++j) { v[j] = xr[64 * j]; s += (v[j].x * v[j].x + v[j].y * v[j].y) + (v[j].z * v[j].z + v[j].w * v[j].w); }
            s = wave_sum(s);
#pragma unroll
            for (int j = 0; j < 8; ++j) { xb8[64 * j] = (unsigned long long)pk2(v[j].x, v[j].y) | ((unsigned long long)pk2(v[j].z, v[j].w) << 32); }
            if (lane == 0) ROWSS[row] = pg8::ss_fix(s);
        }
        for (int c = gw * 64 + lane; c < 1024; c += NGW * 64) {
            const float a0 = hgrn_lb[c], a1 = hgrn_lb[1024 + c], a2 = hgrn_lb[2048 + c], a3 = hgrn_lb[3072 + c];
            const float mx = fmaxf(fmaxf(a0, a1), fmaxf(a2, a3));
            const float e0 = __expf(a0 - mx), e1 = __expf(a1 - mx), e2 = __expf(a2 - mx), e3 = __expf(a3 - mx);
            const float inv = 1.0f / (e0 + e1 + e2 + e3);
            LB[c] = 0.f; LB[1024 + c] = e1 * inv; LB[2048 + c] = (e1 + e2) * inv; LB[3072 + c] = (e1 + e2 + e3) * inv;
        }
    }
    SEAM();

    for (int i = 0; i < 8; ++i) {
        const int l = i >> 1, s = i & 1;
        {
            if (IN(ph)) {
                unsigned char* ws = kargs()->ws; unsigned char* wl = ws + WS_W + (size_t)l * WL_BYTES;
                pg8::Gemm g{WSP(bf16, WS_XB), (const bf16*)(wl + WO_W1 + s * W1_BYTES), M, NUP, DM}; pg8::StaticOrder S; S.init(M, NUP, G, bx);
                pg8::EpiFfnUp E{WSP(bf16, WS_HFF), WSP(pg8::ss_t, WS_ROWSS) + (size_t)(3 * l + 2 * s) * M};
                pg8::gemm_phase<pg8::EpiFfnUp, pg8::StaticOrder, true, true>(lds + RING_OFF, g, S, E, wave);
            }
            SEAM();
            if (IN(ph)) {
                unsigned char* ws = kargs()->ws; unsigned char* wl = ws + WS_W + (size_t)l * WL_BYTES;
                pg8::Gemm g{WSP(bf16, WS_HFF), (const bf16*)(wl + WO_W2 + s * W2_BYTES), M, DM, DFF}; pg8::StaticOrder S; S.init(M, DM, G, bx);
                pg8::EpiResid E{WSP(bf16, WS_XB), WSP(pg8::ss_t, WS_ROWSS) + (size_t)(3 * l + 2 * s + 1) * M, 0.5f, 2.0f};
                pg8::gemm_phase<pg8::EpiResid, pg8::StaticOrder, true, true>(lds + RING_OFF, g, S, E, wave);
            }
            SEAM();
        }
        if (s == 0) {
            if (IN(ph)) {
                const KArgs ka = kargs(); unsigned char* ws = ka->ws; unsigned char* wl = ws + WS_W + (size_t)l * WL_BYTES;
                pg8::Gemm g{WSP(bf16, WS_XB), (const bf16*)(wl + WO_WIN), M, INW, DM}; pg8::StaticOrder S; S.init(M, INW, G, bx);
                pg8::EpiZ E{WSP(bf16, WS_Z), WSP(bf16, WS_Z + 144 * MiB), WSP(unsigned char, WS_Z + 272 * MiB), WSP(float, WS_LOGF), WSP(pg8::ss_t, WS_ROWSS) + (size_t)(3 * l + 1) * M, WSP(float, WS_LB) + l * 1024, ka->in[6] + (size_t)l * 2 * DM};
                pg8::gemm_phase<pg8::EpiZ, pg8::StaticOrder, true, true>(lds + RING_OFF, g, S, E, wave);
            }
            SEAM();
            if (IN(ph)) {
                unsigned char* ws = kargs()->ws;
                hgrn_pass<false>(lds, WSP(bf16, WS_Z + 144 * MiB), WSP(float, WS_LOGF), nullptr, WSP(float, WS_SLOC), WSP(float, WS_DTOT), nullptr, bx, G, wave);
                attn_fast(lds, WSP(bf16, WS_Z), WSP(bf16, WS_AO), WSP(float, WS_LSE), vcu, G, wave);
            }
            SEAM();
            if (IN(ph)) {
                const KArgs ka = kargs(); unsigned char* ws = ka->ws;
                hgrn_pass<true>(lds, WSP(bf16, WS_Z + 144 * MiB), WSP(float, WS_LOGF), ka->in[8] + l * 128, WSP(float, WS_SLOC), WSP(float, WS_DTOT), WSP(bf16, WS_HG), bx, G, wave);
                attn_combine(WSP(bf16, WS_AO), WSP(float, WS_LSE), WSP(bf16, WS_ATT), gw, NGW);
            }
            SEAM();
            if (IN(ph)) {
                unsigned char* ws = kargs()->ws; unsigned char* wl = ws + WS_W + (size_t)l * WL_BYTES;
                { pg8::Gemm g{WSP(bf16, WS_ATT), (const bf16*)(wl + WO_WPA), M, DM, AW}; pg8::StaticOrder S; S.init(M, DM, G, bx);
                  pg8::EpiPa E{WSP(unsigned char, WS_Z + 272 * MiB), WSP(bf16, WS_Y32)};
                  pg8::gemm_phase<pg8::EpiPa, pg8::StaticOrder, true, true>(lds + RING_OFF, g, S, E, wave); }
                { pg8::Gemm g{WSP(bf16, WS_HG), (const bf16*)(wl + WO_WPM), M, DM, HW}; pg8::StaticOrder S; S.init(M, DM, G, bx);
                  pg8::EpiPm E{WSP(unsigned char, WS_Z + 272 * MiB), WSP(bf16, WS_Y32), WSP(bf16, WS_YB)};
                  pg8::gemm_phase<pg8::EpiPm, pg8::StaticOrder, true, true>(lds + RING_OFF, g, S, E, wave); }
            }
            SEAM();
            if (IN(ph)) {
                unsigned char* ws = kargs()->ws; unsigned char* wl = ws + WS_W + (size_t)l * WL_BYTES;
                pg8::Gemm g{WSP(bf16, WS_YB), (const bf16*)(wl + WO_WO), M, DM, DM}; pg8::StaticOrder S; S.init(M, DM, G, bx);
                pg8::EpiResid E{WSP(bf16, WS_XB), WSP(pg8::ss_t, WS_ROWSS) + (size_t)(3 * l + 2) * M, 1.0f, 1.0f};
                pg8::gemm_phase<pg8::EpiResid, pg8::StaticOrder, true, true>(lds + RING_OFF, g, S, E, wave);
            }
            SEAM();
        }
    }
    if (IN(ph)) {
        const KArgs ka = kargs(); unsigned char* ws = ka->ws; const float* final_norm = ka->in[12]; float* out = ka->out;
        const int lane = lane_id_fresh();
        const pg8::ss_t* rs = WSP(pg8::ss_t, WS_ROWSS) + (size_t)12 * M; const bf16* XB = WSP(bf16, WS_XB);
        for (int row = gw; row < M; row += NGW) {
            const float r = pg8::rstd_of(rs[row]);
            const GAS u32x2* xr = (const GAS u32x2*)(XB + (size_t)row * DM) + lane;
            const GAS f32x4* gn = (const GAS f32x4*)final_norm + lane;
            GAS f32x4* orow = (GAS f32x4*)(out + (size_t)row * DM) + lane;
#pragma unroll
            for (int j = 0; j < 8; ++j) { const u32x2 v = xr[64 * j]; const f32x4 g = gn[64 * j]; orow[64 * j] = (f32x4){bflo(v.x) * r * g.x, bfhi(v.x) * r * g.y, bflo(v.y) * r * g.z, bfhi(v.y) * r * g.w}; }
        }
    }
#undef IN
#undef SEAM
#undef WSP
}

extern "C" void kernel_launch(void* const* d_in, const int* in_sizes, int n_in, void* d_out, int out_size, void* d_ws, size_t ws_size, hipStream_t stream) {
    static int grid = 0;
    if (grid == 0) {
        if (n_in != 13 || in_sizes[0] != M * DM || out_size != M * DM || ws_size < WS_END) { fprintf(stderr, "kernel_launch: unexpected shapes (n_in %d, in0 %d, out %d, ws %zu < %zu?); nothing launched\n", n_in, n_in > 0 ? in_sizes[0] : -1, out_size, ws_size, (size_t)WS_END); grid = -1; return; }
        int dev = 0, cus = 0, per_cu = 0;
        if (hipGetDevice(&dev) != hipSuccess || hipDeviceGetAttribute(&cus, hipDeviceAttributeMultiprocessorCount, dev) != hipSuccess) { grid = -1; return; }
        if (hipFuncSetAttribute((const void*)mk_fwd, hipFuncAttributeMaxDynamicSharedMemorySize, LDS_BYTES) != hipSuccess) { fprintf(stderr, "kernel_launch: hipFuncSetAttribute failed\n"); grid = -1; return; }
        if (hipOccupancyMaxActiveBlocksPerMultiprocessor(&per_cu, (const void*)mk_fwd, NWAVES * 64, LDS_BYTES) != hipSuccess || per_cu < 1) { fprintf(stderr, "kernel_launch: occupancy query says %d blocks per CU\n", per_cu); }
        (void)hipGetLastError();
        grid = cus;
    }
    if (grid < 0) return;
    if (hipMemsetAsync((char*)d_ws + WS_CTL, 0, CTL_ZERO_BYTES, stream) != hipSuccess) { fprintf(stderr, "kernel_launch: memset failed\n"); return; }
    Args a{};
    for (int i = 0; i < 13; ++i) a.in[i] = (const float*)d_in[i];
    a.out = (float*)d_out; a.ws = (unsigned char*)d_ws;
#if MK_ONE_LAUNCH
    a.ph_lo = 0; a.ph_hi = N_PHASES;
    hipLaunchKernelGGL(mk_fwd, dim3(grid), dim3(NWAVES * 64), LDS_BYTES, stream, a);
#else
    for (int p = 0; p < N_PHASES; ++p) { a.ph_lo = p; a.ph_hi = p + 1; hipLaunchKernelGGL(mk_fwd, dim3(grid), dim3(NWAVES * 64), LDS_BYTES, stream, a); }
#endif
    const hipError_t le = hipPeekAtLastError();
    if (le != hipSuccess) fprintf(stderr, "kernel_launch: launch failed: %s\n", hipGetErrorName(le));
}
```
